# Optimizing an MI355X kernel written in HIP

```python
import jax, jax.numpy as jnp
from jax import lax
import numpy as np

D_MODEL = 1024
BATCH = 4
SEQ = 8192
DEPTH = 1

GLA_HEADS = 4
GLA_DK = 64
GLA_DV = 128
GLA_GATE_RANK = 16
GLA_GATE_TEMP = 16.0
GLA_CHUNK = 64
SWA_HEADS = 8
SWA_KV_HEADS = 2
SWA_HEAD_DIM = 64
SWA_WINDOW = 128
SWA_BLOCK = 128
PEER_HEADS = 8
PEER_N_KEYS = 128
PEER_N_EXPERTS = PEER_N_KEYS * PEER_N_KEYS
PEER_QUERY_DIM = 256
PEER_TOPK = 16
PEER_TOKEN_BLOCK = 128
RMS_EPS = 1e-6

GLA_QK_WIDTH = GLA_HEADS * GLA_DK
GLA_WIDTH = GLA_HEADS * GLA_DV
SWA_WIDTH = SWA_HEADS * SWA_HEAD_DIM
SWA_KV_WIDTH = SWA_KV_HEADS * SWA_HEAD_DIM
MIX_WIDTH = GLA_WIDTH + SWA_WIDTH
IN_WIDTH = 2 * GLA_QK_WIDTH + GLA_WIDTH + GLA_GATE_RANK + GLA_WIDTH + SWA_WIDTH + 2 * SWA_KV_WIDTH

kernel_name = "hymba_gla_swa_peer_adaln"


def rms_norm(t, g):
    tf = t.astype(jnp.float32)
    tf = tf * lax.rsqrt(jnp.mean(tf * tf, axis=-1, keepdims=True) + RMS_EPS)
    return (tf * g.astype(jnp.float32)).astype(t.dtype)


def modulate(t, g, shift, scale):
    return rms_norm(t, g) * (1 + scale[:, None, :]) + shift[:, None, :]


def gla_mixer(q, k, v, log_a):
    bsz, s = q.shape[0], q.shape[1]
    nc = s // GLA_CHUNK

    def to_chunks(t):
        return t.astype(jnp.float32).reshape(bsz, nc, GLA_CHUNK, GLA_HEADS, -1).transpose(1, 0, 3, 2, 4)

    causal = jnp.tril(jnp.ones((GLA_CHUNK, GLA_CHUNK), dtype=bool))

    def step(state, inp):
        qc, kc, vc, ac = inp
        b = jnp.cumsum(ac, axis=2)
        o_inter = jnp.einsum('bhtk,bhkv->bhtv', qc * jnp.exp(b), state)
        diff = b[:, :, :, None, :] - b[:, :, None, :, :]
        decay = jnp.exp(jnp.where(causal[None, None, :, :, None], diff, -jnp.inf))
        scores = jnp.einsum('bhtk,bhsk,bhtsk->bhts', qc, kc, decay)
        o_intra = jnp.einsum('bhts,bhsv->bhtv', scores, vc)
        b_last = b[:, :, -1:, :]
        state = jnp.exp(b_last[:, :, 0, :, None]) * state + jnp.einsum(
            'bhsk,bhsv->bhkv', kc * jnp.exp(b_last - b), vc)
        return state, o_inter + o_intra

    init = jnp.zeros((bsz, GLA_HEADS, GLA_DK, GLA_DV), jnp.float32)
    xs = (to_chunks(q * GLA_DK ** -0.5), to_chunks(k), to_chunks(v), to_chunks(log_a))
    _, o = lax.scan(step, init, xs)
    return o.transpose(1, 0, 3, 2, 4).reshape(bsz, s, GLA_HEADS, GLA_DV).astype(v.dtype)


def swa_mixer(q, k, v, sinks):
    bsz, s = q.shape[0], q.shape[1]
    nb = s // SWA_BLOCK
    grp = SWA_HEADS // SWA_KV_HEADS
    qb = q.reshape(bsz, nb, SWA_BLOCK, SWA_KV_HEADS, grp, SWA_HEAD_DIM) * SWA_HEAD_DIM ** -0.5

    def with_prev(t):
        tb = t.reshape(bsz, nb, SWA_BLOCK, SWA_KV_HEADS, SWA_HEAD_DIM)
        prev = jnp.pad(tb, ((0, 0), (1, 0), (0, 0), (0, 0), (0, 0)))[:, :-1]
        return jnp.concatenate([prev, tb], axis=2)

    kb, vb = with_prev(k), with_prev(v)
    sc = jnp.einsum('bnqhgd,bnkhd->bnhgqk', qb, kb).astype(jnp.float32)
    qi = jnp.arange(SWA_BLOCK)[:, None]
    kj = jnp.arange(2 * SWA_BLOCK)[None, :]
    dist = qi + SWA_BLOCK - kj
    key_pos = jnp.arange(nb)[:, None] * SWA_BLOCK - SWA_BLOCK + kj[0][None, :]
    valid = ((dist >= 0) & (dist < SWA_WINDOW))[None] & (key_pos >= 0)[:, None, :]
    slopes = (2.0 ** (-8.0 * (jnp.arange(SWA_HEADS) + 1) / SWA_HEADS)).astype(jnp.float32)
    slopes = slopes.reshape(SWA_KV_HEADS, grp)[None, None, :, :, None, None]
    sc = sc - slopes * dist.astype(jnp.float32)
    sc = jnp.where(valid[None, :, None, None], sc, -jnp.inf)
    sink = sinks.astype(jnp.float32).reshape(SWA_KV_HEADS, grp)[None, None, :, :, None, None]
    m = jnp.maximum(jnp.max(sc, axis=-1, keepdims=True), sink)
    p = jnp.exp(sc - m)
    p = p / (jnp.sum(p, axis=-1, keepdims=True) + jnp.exp(sink - m))
    o = jnp.einsum('bnhgqk,bnkhd->bnqhgd', p.astype(vb.dtype), vb)
    return o.reshape(bsz, s, SWA_WIDTH)


def peer_mixer(h, w_q, keys_1, keys_2, u_tab, v_tab):
    bsz, s, d = h.shape
    t = bsz * s
    hf = h.reshape(t, d)
    q = (hf @ w_q).reshape(t, PEER_HEADS, PEER_QUERY_DIM)
    half = PEER_QUERY_DIM // 2
    s1 = jnp.einsum('thd,nd->thn', q[..., :half], keys_1).astype(jnp.float32)
    s2 = jnp.einsum('thd,nd->thn', q[..., half:], keys_2).astype(jnp.float32)
    v1, i1 = lax.top_k(s1, PEER_TOPK)
    v2, i2 = lax.top_k(s2, PEER_TOPK)
    cand = (v1[..., :, None] + v2[..., None, :]).reshape(t, PEER_HEADS, PEER_TOPK * PEER_TOPK)
    sc, ci = lax.top_k(cand, PEER_TOPK)
    e1 = jnp.take_along_axis(i1, ci // PEER_TOPK, axis=-1)
    e2 = jnp.take_along_axis(i2, ci % PEER_TOPK, axis=-1)
    experts = (e1 * PEER_N_KEYS + e2).reshape(t, PEER_HEADS * PEER_TOPK)
    gates = jax.nn.softmax(sc, axis=-1).reshape(t, PEER_HEADS * PEER_TOPK)
    nblk = t // PEER_TOKEN_BLOCK

    def expert_block(args):
        hb, eb, gb = args
        a = jax.nn.gelu(jnp.einsum('td,ted->te', hb, u_tab[eb]).astype(jnp.float32), approximate=False)
        w = (gb * a).astype(hb.dtype)
        return jnp.einsum('te,ted->td', w, v_tab[eb])

    out = lax.map(expert_block, (hf.reshape(nblk, PEER_TOKEN_BLOCK, d),
                                 experts.reshape(nblk, PEER_TOKEN_BLOCK, -1),
                                 gates.reshape(nblk, PEER_TOKEN_BLOCK, -1)))
    return out.reshape(bsz, s, d)


def setup_inputs(seed: int = 0) -> dict:
    key = jax.random.key(seed)
    ks = jax.random.split(key, 24)
    f32 = jnp.float32
    n = lambda k, shape, sc: (jax.random.normal(k, shape, f32) * sc)
    gain = lambda k, shape: 1.0 + 0.02 * jax.random.normal(k, shape, f32)
    half = PEER_QUERY_DIM // 2
    return {
        "x": n(ks[0], (BATCH, SEQ, D_MODEL), 1.0),
        "c": n(ks[1], (BATCH, D_MODEL), 1.0),
        "w_ada": n(ks[2], (DEPTH, D_MODEL, 6 * D_MODEL), 0.5 * D_MODEL ** -0.5),
        "b_ada": n(ks[3], (DEPTH, 6 * D_MODEL), 0.02),
        "norm1_g": gain(ks[4], (DEPTH, D_MODEL)),
        "norm2_g": gain(ks[5], (DEPTH, D_MODEL)),
        "w_in": n(ks[6], (DEPTH, D_MODEL, IN_WIDTH), D_MODEL ** -0.5),
        "w_gla_alpha": n(ks[7], (DEPTH, GLA_GATE_RANK, GLA_QK_WIDTH), GLA_GATE_RANK ** -0.5),
        "b_gla_alpha": n(ks[8], (DEPTH, GLA_QK_WIDTH), 0.1),
        "gla_norm_g": gain(ks[9], (DEPTH, GLA_WIDTH)),
        "swa_sinks": n(ks[10], (DEPTH, SWA_HEADS), 0.5),
        "swa_norm_g": gain(ks[11], (DEPTH, SWA_WIDTH)),
        "w_out": n(ks[12], (DEPTH, MIX_WIDTH, D_MODEL), MIX_WIDTH ** -0.5),
        "w_peer_q": n(ks[13], (DEPTH, D_MODEL, PEER_HEADS * PEER_QUERY_DIM), D_MODEL ** -0.5),
        "peer_keys_1": n(ks[14], (DEPTH, PEER_N_KEYS, half), half ** -0.5),
        "peer_keys_2": n(ks[15], (DEPTH, PEER_N_KEYS, half), half ** -0.5),
        "peer_u": n(ks[16], (DEPTH, PEER_N_EXPERTS, D_MODEL), D_MODEL ** -0.5),
        "peer_v": n(ks[17], (DEPTH, PEER_N_EXPERTS, D_MODEL), 0.2),
        "final_g": gain(ks[18], (D_MODEL,)),
    }


def reference(x, c, w_ada, b_ada, norm1_g, norm2_g, w_in, w_gla_alpha, b_gla_alpha, gla_norm_g,
              swa_sinks, swa_norm_g, w_out, w_peer_q, peer_keys_1, peer_keys_2, peer_u, peer_v, final_g):
    bsz, s, _ = x.shape
    widths = (GLA_QK_WIDTH, GLA_QK_WIDTH, GLA_WIDTH, GLA_GATE_RANK, GLA_WIDTH, SWA_WIDTH, SWA_KV_WIDTH, SWA_KV_WIDTH)
    split_at = [int(v) for v in np.cumsum(widths)[:-1]]
    c_act = jax.nn.silu(c)
    for l in range(DEPTH):
        mod = c_act @ w_ada[l] + b_ada[l]
        shift1, scale1, gate1, shift2, scale2, gate2 = jnp.split(mod, 6, axis=-1)

        h = modulate(x, norm1_g[l], shift1, scale1)
        proj = h @ w_in[l]
        q_g, k_g, v_g, a_lr, r_g, q_s, k_s, v_s = jnp.split(proj, split_at, axis=-1)
        log_a = jax.nn.log_sigmoid((a_lr @ w_gla_alpha[l] + b_gla_alpha[l]).astype(jnp.float32)) / GLA_GATE_TEMP
        o_gla = gla_mixer(q_g.reshape(bsz, s, GLA_HEADS, GLA_DK),
                          k_g.reshape(bsz, s, GLA_HEADS, GLA_DK),
                          v_g.reshape(bsz, s, GLA_HEADS, GLA_DV),
                          log_a.reshape(bsz, s, GLA_HEADS, GLA_DK))
        o_gla = rms_norm(o_gla, gla_norm_g[l].reshape(GLA_HEADS, GLA_DV)).reshape(bsz, s, GLA_WIDTH)
        o_gla = o_gla * jax.nn.silu(r_g)
        o_swa = swa_mixer(q_s.reshape(bsz, s, SWA_HEADS, SWA_HEAD_DIM),
                          k_s.reshape(bsz, s, SWA_KV_HEADS, SWA_HEAD_DIM),
                          v_s.reshape(bsz, s, SWA_KV_HEADS, SWA_HEAD_DIM),
                          swa_sinks[l])
        o_swa = rms_norm(o_swa, swa_norm_g[l])
        y = jnp.concatenate([o_gla, o_swa], axis=-1) @ w_out[l]
        x = x + gate1[:, None, :] * y

        h2 = modulate(x, norm2_g[l], shift2, scale2)
        x = x + gate2[:, None, :] * peer_mixer(h2, w_peer_q[l], peer_keys_1[l], peer_keys_2[l], peer_u[l], peer_v[l])
    return rms_norm(x, final_g)
```

```cpp
#include <hip/hip_runtime.h>
#include <cstdio>
#include <cstdint>
#include <cmath>

#ifndef ONE_LAUNCH
#define ONE_LAUNCH 0
#endif
#ifndef NAIVE_GEMM
#define NAIVE_GEMM 0
#endif
#ifndef NAIVE_GLA
#define NAIVE_GLA 1
#endif
#ifndef NAIVE_SWA
#define NAIVE_SWA 1
#endif

constexpr int DM = 1024, NB = 4, SEQ = 8192, NT = NB * SEQ;
constexpr int GLA_H = 4, GLA_DK = 64, GLA_DV = 128, GLA_RANK = 16, GLA_CHUNK = 64;
constexpr int SWA_H = 8, SWA_KV = 2, SWA_HD = 64, SWA_W = 128;
constexpr int PEER_H = 8, PEER_NK = 128, PEER_NE = PEER_NK * PEER_NK, PEER_QD = 256, PEER_K = 16;
constexpr int IN_W = 2320;
constexpr float RMS_EPS = 1e-6f;
constexpr int PROJ_W = 2304, NPAD = 2560;
constexpr int C_QG = 0, C_KG = 256, C_VG = 512, C_RG = 1024, C_QS = 1536, C_KS = 2048, C_VS = 2176;
constexpr int NTHREADS = 512, NWAVES = 8;

constexpr size_t MiB = 1u << 20;
constexpr size_t WS_CTL = 0, CTL_ZERO_BYTES = 64 * 1024;
constexpr size_t WS_MOD = 1 * MiB;
constexpr size_t WS_WTIN = 2 * MiB;
constexpr size_t WS_WTOUT = 7 * MiB;
constexpr size_t WS_WTPK = 9 * MiB;
constexpr size_t WS_GU = 13 * MiB;
constexpr size_t WS_GD = 21 * MiB;
constexpr size_t WS_UBF = 22 * MiB;
constexpr size_t WS_VBF = 54 * MiB;
constexpr size_t WS_H = 86 * MiB;
constexpr size_t WS_PROJ = 150 * MiB;
constexpr size_t WS_LOGA = 294 * MiB;
constexpr size_t WS_OMIX = 326 * MiB;
constexpr size_t WS_SKEY = 150 * MiB;
constexpr size_t WS_END = 406 * MiB;

typedef unsigned short bf16_t;
typedef unsigned u32x4_t __attribute__((ext_vector_type(4)));
typedef unsigned u32x2_t __attribute__((ext_vector_type(2)));
typedef float f32x4_t __attribute__((ext_vector_type(4)));
#define LAS __attribute__((address_space(3)))

struct Params {
    const float *x, *c, *w_ada, *b_ada, *norm1_g, *norm2_g, *w_in, *w_gla_alpha, *b_gla_alpha, *gla_norm_g, *swa_sinks, *swa_norm_g, *w_out, *w_peer_q,
        *peer_keys_1, *peer_keys_2, *peer_u, *peer_v, *final_g;
    float* out; unsigned char* ws;
};

__device__ __forceinline__ float bf2f(unsigned v) { return __uint_as_float(v << 16); }
__device__ __forceinline__ float bflo(unsigned w) { return __uint_as_float(w << 16); }
__device__ __forceinline__ float bfhi(unsigned w) { return __uint_as_float(w & 0xffff0000u); }
__device__ __forceinline__ unsigned f2bf(float f) { unsigned u = __float_as_uint(f); return (u + 0x7fffu + ((u >> 16) & 1u)) >> 16; }
__device__ __forceinline__ unsigned pk2(float lo, float hi) { return f2bf(lo) | (f2bf(hi) << 16); }
__device__ __forceinline__ float wave_sum(float v) {
#pragma unroll
    for (int o = 1; o < 64; o <<= 1) v += __shfl_xor(v, o);
    return v;
}
__device__ __forceinline__ float silu_f(float v) { return v / (1.f + __expf(-v)); }
__device__ __forceinline__ unsigned f2key(float f) { unsigned u = __float_as_uint(f); return u ^ ((u >> 31) ? 0xffffffffu : 0x80000000u); }
__device__ __forceinline__ float key2f(unsigned k) { unsigned u = k ^ ((k >> 31) ? 0x80000000u : 0xffffffffu); return __uint_as_float(u); }

namespace pg8 {
#define PG8_LAS __attribute__((address_space(3)))
typedef unsigned short bf16_t;
typedef short bf16x8 __attribute__((ext_vector_type(8)));
typedef float f32x4 __attribute__((ext_vector_type(4)));
typedef unsigned u32x4 __attribute__((ext_vector_type(4)));
constexpr int BM = 256, BK = 64, HALF = 128, HTB = HALF * BK * 2  , STAGE_BYTES = 8 * HTB, NXCD = 8, WGM = 8;

__host__ __device__ __forceinline__ int lds_byte(int r, int c) { const int st = (r >> 4) * 2 + (c >> 5), rr = r & 15, cc = c & 31, ob = rr * 64 + cc * 2; return st * 1024 + (ob ^ (((ob >> 9) & 1) << 5)); }
__host__ __device__ __forceinline__ void stage_rc(int b, int& R, int& C) { const int st = b / 1024, sb = b % 1024, swz = sb ^ (((sb >> 9) & 1) << 5); R = (st >> 1) * 16 + swz / 64; C = (st & 1) * 32 + (swz % 64) / 2; }
__host__ __device__ __forceinline__ int perm32(int rho) { const int n = rho >> 4, i = rho & 15; return 8 * (i >> 2) + 4 * n + (i & 3); }

struct Unit { int pm, pn; };
struct Gemm { const bf16_t* A; const bf16_t* Bt; int M, N, K; };

struct StaticOrder {
    int nM, nN, nwg, G, c;
    __host__ __device__ void init(int M, int N, int G_, int c_) { nM = M / BM; nN = N / BM; nwg = nM * nN; G = G_; c = c_; }
    __host__ __device__ bool next(int i, Unit& u) const {
        const long L = (long)i * G + c; if (L >= nwg) return false;
        int wgid = (int)L; { const int q = nwg / NXCD, r = nwg % NXCD, xcd = wgid % NXCD, off = wgid / NXCD; wgid = (xcd < r ? xcd * (q + 1) : r * (q + 1) + (xcd - r) * q) + off; }
        const int nig = WGM * nN, gid = wgid / nig, fm = gid * WGM, gsz = (nM - fm) < WGM ? (nM - fm) : WGM;
        u.pm = fm + ((wgid % nig) % gsz); u.pn = (wgid % nig) / gsz; return true;
    }
    __device__ __forceinline__ void a_ready(const Unit&) const {}
    __device__ __forceinline__ void done(const Unit&) const {}
};

__device__ __forceinline__ unsigned cvt_pk_bf16(float lo, float hi) { unsigned r; asm volatile("v_cvt_pk_bf16_f32 %0, %1, %2" : "=v"(r) : "v"(lo), "v"(hi)); return r; }
typedef float f32x2 __attribute__((ext_vector_type(2)));
template <class Epi, class Sched, bool ALIGN_EPI = false, bool SP2 = false>
__device__ __forceinline__ void gemm_phase(PG8_LAS unsigned char* lds, const Gemm g, const Sched& S, const Epi& E) {
    const int tid = threadIdx.x, wid = __builtin_amdgcn_readfirstlane(tid >> 6), lane = tid & 63, wr = wid >> 2, wc = wid & 3, fr = lane & 15, fq = lane >> 4;
    const int K = g.K, nt = K / BK;
    unsigned voffA[2], voffB[2];
#pragma unroll
    for (int i = 0; i < 2; ++i) { int R, C; stage_rc(tid * 16 + i * 8192, R, C); const int Rb = Epi::PERM ? ((R & ~31) + perm32(R & 31)) : R;
        voffA[i] = (unsigned)(R * K + C) * 2u; voffB[i] = (unsigned)(Rb * K + C) * 2u; }
    const size_t kstep = (size_t)(BK * 2);
    const size_t hstep = (size_t)HALF * K * 2;
    const size_t tstep = 2 * hstep;
    const unsigned ldsw = (unsigned)wid * 1024u;
    const int aoff = lds_byte(wr * 64 + fr, fq * 8), boff = lds_byte(wc * 32 + fr, fq * 8);
#define PG8_SA(b, h) (((b) * 2 + (h)) * HTB)
#define PG8_SB(b, h) ((4 + (b) * 2 + (h)) * HTB)
#define PG8_STAGE(bufoff, gbase, voff) do { _Pragma("unroll") for (int _i = 0; _i < 2; ++_i) \
        __builtin_amdgcn_global_load_lds((const unsigned*)((const char*)(gbase) + (voff)[_i]), (PG8_LAS unsigned*)(lds + (bufoff) + ldsw + _i * 8192), 16, 0, 0); } while (0)
#define PG8_LDA(dst, b, h) do { _Pragma("unroll") for (int m = 0; m < 4; ++m) _Pragma("unroll") for (int k = 0; k < 2; ++k) dst[m][k] = *(const PG8_LAS bf16x8*)(lds + PG8_SA(b, h) + aoff + m * 2048 + k * 1024); } while (0)
#define PG8_LDB(dst, b, h) do { _Pragma("unroll") for (int n = 0; n < 2; ++n) _Pragma("unroll") for (int k = 0; k < 2; ++k) dst[n][k] = *(const PG8_LAS bf16x8*)(lds + PG8_SB(b, h) + boff + n * 2048 + k * 1024); } while (0)
#define PG8_MMA(ai, bj, At, Bt) do { __builtin_amdgcn_s_setprio(1); _Pragma("unroll") for (int m = 0; m < 4; ++m) _Pragma("unroll") for (int n = 0; n < 2; ++n) _Pragma("unroll") for (int k = 0; k < 2; ++k) \
        acc[ai][bj][m][n] = __builtin_amdgcn_mfma_f32_16x16x32_bf16(Bt[n][k], At[m][k], acc[ai][bj][m][n], 0, 0, 0); __builtin_amdgcn_s_setprio(0); } while (0)
#define PG8_WAIT_V(n) asm volatile("s_waitcnt vmcnt(" #n ")" ::: "memory")
#define PG8_WAIT_L(n) asm volatile("s_waitcnt lgkmcnt(" #n ")" ::: "memory")
#define PG8_BAR __builtin_amdgcn_s_barrier()
#define PG8_SCHED __builtin_amdgcn_sched_barrier(0)
    Unit cur, nxt; int ui = 0;
    if (!S.next(0, cur)) return;
    f32x4 acc[2][2][4][2];
#pragma unroll
    for (int a = 0; a < 2; ++a)
#pragma unroll
        for (int b = 0; b < 2; ++b)
#pragma unroll
            for (int m = 0; m < 4; ++m)
#pragma unroll
                for (int n = 0; n < 2; ++n) acc[a][b][m][n] = (f32x4){0.f, 0.f, 0.f, 0.f};
    bf16x8 At[4][2], B0[2][2], B1[2][2];
    const char* cA = (const char*)g.A + (size_t)cur.pm * tstep; const char* cB = (const char*)g.Bt + (size_t)cur.pn * tstep;
    S.a_ready(cur);
    if constexpr (SP2) {
        PG8_STAGE(PG8_SB(0, 0), cB, voffB); PG8_STAGE(PG8_SB(0, 1), cB + hstep, voffB); PG8_STAGE(PG8_SA(0, 0), cA, voffA); PG8_STAGE(PG8_SA(0, 1), cA + hstep, voffA);
        if (wr == 1) PG8_BAR;
        PG8_WAIT_V(2); PG8_BAR;
        PG8_STAGE(PG8_SB(1, 0), cB + kstep, voffB); PG8_STAGE(PG8_SA(1, 0), cA + kstep, voffA); PG8_STAGE(PG8_SB(1, 1), cB + hstep + kstep, voffB);
        PG8_WAIT_V(6); PG8_BAR;
    } else {
        PG8_STAGE(PG8_SB(0, 0), cB, voffB); PG8_STAGE(PG8_SA(0, 0), cA, voffA); PG8_STAGE(PG8_SB(0, 1), cB + hstep, voffB); PG8_STAGE(PG8_SA(0, 1), cA + hstep, voffA);
        if (wr == 1) PG8_BAR;
        PG8_WAIT_V(4); PG8_BAR;
        PG8_STAGE(PG8_SB(1, 0), cB + kstep, voffB); PG8_STAGE(PG8_SA(1, 0), cA + kstep, voffA); PG8_STAGE(PG8_SB(1, 1), cB + hstep + kstep, voffB);
        PG8_WAIT_V(6); PG8_BAR;
    }
    for (;;) {
        const bool has_next = S.next(ui + 1, nxt);
        const char* nA = has_next ? (const char*)g.A + (size_t)nxt.pm * tstep : cA; const char* nB = has_next ? (const char*)g.Bt + (size_t)nxt.pn * tstep : cB;
        for (int t = 0; t < nt; t += 2) {
            const bool last = (t == nt - 2);
            const char* a1 = cA + (size_t)(t + 1) * kstep;
            const char* a2 = last ? nA : cA + (size_t)(t + 2) * kstep; const char* b2 = last ? nB : cB + (size_t)(t + 2) * kstep;
            const char* a3 = a2 + kstep; const char* b3 = b2 + kstep;
            if (last && has_next) S.a_ready(nxt);
            if constexpr (SP2) {
            PG8_LDB(B0, 0, 0); PG8_LDB(B1, 0, 1); PG8_SCHED; PG8_LDA(At, 0, 0); PG8_STAGE(PG8_SA(1, 1), a1 + hstep, voffA);
            PG8_WAIT_V(8); PG8_WAIT_L(0); PG8_BAR; PG8_MMA(0, 0, At, B0); PG8_MMA(0, 1, At, B1); PG8_BAR; PG8_SCHED;
            PG8_LDA(At, 0, 1); PG8_STAGE(PG8_SB(0, 0), b2, voffB); PG8_STAGE(PG8_SB(0, 1), b2 + hstep, voffB); PG8_STAGE(PG8_SA(0, 0), a2, voffA);
            PG8_WAIT_V(8); PG8_WAIT_L(0); PG8_BAR; PG8_MMA(1, 0, At, B0); PG8_MMA(1, 1, At, B1); PG8_BAR; PG8_SCHED;
            PG8_LDB(B0, 1, 0); PG8_LDB(B1, 1, 1); PG8_SCHED; PG8_LDA(At, 1, 0); PG8_STAGE(PG8_SA(0, 1), a2 + hstep, voffA);
            PG8_WAIT_V(8); PG8_WAIT_L(0); PG8_BAR; PG8_MMA(0, 0, At, B0); PG8_MMA(0, 1, At, B1); PG8_BAR; PG8_SCHED;
            PG8_LDA(At, 1, 1); PG8_STAGE(PG8_SB(1, 0), b3, voffB); PG8_STAGE(PG8_SB(1, 1), b3 + hstep, voffB); PG8_STAGE(PG8_SA(1, 0), a3, voffA);
            PG8_WAIT_V(8); PG8_WAIT_L(0); PG8_BAR; PG8_MMA(1, 0, At, B0); PG8_MMA(1, 1, At, B1); PG8_BAR; PG8_SCHED;
            } else {
            PG8_LDB(B0, 0, 0); PG8_SCHED; PG8_LDA(At, 0, 0); PG8_STAGE(PG8_SA(1, 1), a1 + hstep, voffA);
            PG8_WAIT_L(8); PG8_BAR; PG8_WAIT_L(0); PG8_MMA(0, 0, At, B0); PG8_BAR; PG8_SCHED;
            PG8_LDB(B1, 0, 1); PG8_STAGE(PG8_SB(0, 0), b2, voffB);
            PG8_BAR; PG8_WAIT_L(0); PG8_MMA(0, 1, At, B1); PG8_BAR;
            PG8_LDA(At, 0, 1); PG8_STAGE(PG8_SA(0, 0), a2, voffA);
            PG8_BAR; PG8_WAIT_L(0); PG8_MMA(1, 0, At, B0); PG8_BAR; PG8_SCHED;
            PG8_STAGE(PG8_SB(0, 1), b2 + hstep, voffB);
            PG8_WAIT_V(6); PG8_BAR; PG8_MMA(1, 1, At, B1); PG8_BAR;
            PG8_LDB(B0, 1, 0); PG8_SCHED; PG8_LDA(At, 1, 0); PG8_STAGE(PG8_SA(0, 1), a2 + hstep, voffA);
            PG8_WAIT_L(8); PG8_BAR; PG8_WAIT_L(0); PG8_MMA(0, 0, At, B0); PG8_BAR; PG8_SCHED;
            PG8_LDB(B1, 1, 1); PG8_STAGE(PG8_SB(1, 0), b3, voffB);
            PG8_BAR; PG8_WAIT_L(0); PG8_MMA(0, 1, At, B1); PG8_BAR;
            PG8_LDA(At, 1, 1); PG8_STAGE(PG8_SA(1, 0), a3, voffA);
            PG8_BAR; PG8_WAIT_L(0); PG8_MMA(1, 0, At, B0); PG8_BAR; PG8_SCHED;
            PG8_STAGE(PG8_SB(1, 1), b3 + hstep, voffB);
            PG8_WAIT_V(6); PG8_BAR; PG8_MMA(1, 1, At, B1); PG8_BAR;
            }
        }
        if constexpr (ALIGN_EPI) { if (wr == 0) PG8_BAR; }
        if constexpr (!Epi::AFTER_DRAIN) { E(acc, cur, wr, wc, fr, fq); S.done(cur); }
        if (!has_next) break;
#pragma unroll
        for (int a = 0; a < 2; ++a)
#pragma unroll
            for (int b = 0; b < 2; ++b)
#pragma unroll
                for (int m = 0; m < 4; ++m)
#pragma unroll
                    for (int n = 0; n < 2; ++n) acc[a][b][m][n] = (f32x4){0.f, 0.f, 0.f, 0.f};
        cur = nxt; cA = nA; cB = nB; ++ui;
        if constexpr (ALIGN_EPI) { if (wr == 1) PG8_BAR; }
    }
    PG8_WAIT_V(0);
    if constexpr (!ALIGN_EPI) { if (wr == 0) PG8_BAR; }
    PG8_BAR;
    if constexpr (Epi::AFTER_DRAIN) { E.fused(acc, cur, wr, wc, fr, fq, lds, wid, lane); S.done(cur); }
#undef PG8_SA
#undef PG8_SB
#undef PG8_STAGE
#undef PG8_LDA
#undef PG8_LDB
#undef PG8_MMA
#undef PG8_WAIT_V
#undef PG8_WAIT_L
#undef PG8_BAR
#undef PG8_SCHED
}
}

struct EpiProj {
    static constexpr bool PERM = true, AFTER_DRAIN = false;
    bf16_t* proj; float* loga; const float* balpha;
    __device__ __forceinline__ void operator()(const pg8::f32x4 (&acc)[2][2][4][2], const pg8::Unit& u, int wr, int wc, int fr, int fq) const {
        const int row0 = u.pm * 256 + wr * 64 + fr;
        if (u.pn < 9) {
            const float sc = (u.pn == 0 || u.pn == 6 || u.pn == 7) ? 0.125f : 1.f;
            const int col0 = u.pn * 256 + wc * 32 + 8 * fq;
#pragma unroll
            for (int ai = 0; ai < 2; ++ai)
#pragma unroll
                for (int m = 0; m < 4; ++m) { bf16_t* rowp = proj + (size_t)(row0 + ai * 128 + m * 16) * PROJ_W + col0;
#pragma unroll
                    for (int bj = 0; bj < 2; ++bj) { const pg8::f32x4 v0 = acc[ai][bj][m][0] * sc, v1 = acc[ai][bj][m][1] * sc;
                        u32x4_t w; w.x = pk2(v0[0], v0[1]); w.y = pk2(v0[2], v0[3]); w.z = pk2(v1[0], v1[1]); w.w = pk2(v1[2], v1[3]);
                        *(u32x4_t*)(rowp + bj * 128) = w; } }
        } else {
            const int col0 = wc * 32 + 8 * fq;
#pragma unroll
            for (int bj = 0; bj < 2; ++bj)
#pragma unroll
                for (int n = 0; n < 2; ++n) { const f32x4_t bv = *(const f32x4_t*)(balpha + col0 + bj * 128 + 4 * n);
#pragma unroll
                    for (int ai = 0; ai < 2; ++ai)
#pragma unroll
                        for (int m = 0; m < 4; ++m) { f32x4_t z = acc[ai][bj][m][n] + bv, o;
#pragma unroll
                            for (int j = 0; j < 4; ++j) o[j] = (fminf(z[j], 0.f) - log1pf(__expf(-fabsf(z[j])))) * 0.0625f;
                            *(f32x4_t*)(loga + (size_t)(row0 + ai * 128 + m * 16) * 256 + col0 + bj * 128 + 4 * n) = o; } }
        }
    }
};
struct EpiOut {
    static constexpr bool PERM = false, AFTER_DRAIN = false;
    const float* x; const float* mod; float* out;
    __device__ __forceinline__ void operator()(const pg8::f32x4 (&acc)[2][2][4][2], const pg8::Unit& u, int wr, int wc, int fr, int fq) const {
        const int row0 = u.pm * 256 + wr * 64 + fr, col0 = u.pn * 256 + wc * 32 + 4 * fq;
        const float* g1 = mod + (size_t)((u.pm * 256) / SEQ) * 6144 + 2048;
#pragma unroll
        for (int bj = 0; bj < 2; ++bj)
#pragma unroll
            for (int n = 0; n < 2; ++n) { const int c = col0 + bj * 128 + n * 16; const f32x4_t gv = *(const f32x4_t*)(g1 + c);
#pragma unroll
                for (int ai = 0; ai < 2; ++ai)
#pragma unroll
                    for (int m = 0; m < 4; ++m) { const size_t off = (size_t)(row0 + ai * 128 + m * 16) * DM + c;
                        const f32x4_t xv = *(const f32x4_t*)(x + off); *(f32x4_t*)(out + off) = xv + gv * acc[ai][bj][m][n]; } }
    }
};
struct EpiKey {
    static constexpr bool PERM = false, AFTER_DRAIN = false;
    unsigned* skey;
    __device__ __forceinline__ void operator()(const pg8::f32x4 (&acc)[2][2][4][2], const pg8::Unit& u, int wr, int wc, int fr, int fq) const {
        const int row0 = u.pm * 256 + wr * 64 + fr, col0 = u.pn * 256 + wc * 32 + 4 * fq;
#pragma unroll
        for (int bj = 0; bj < 2; ++bj)
#pragma unroll
            for (int n = 0; n < 2; ++n) { const int c = col0 + bj * 128 + n * 16; const unsigned ib = 127u - (unsigned)(c & 127);
#pragma unroll
                for (int ai = 0; ai < 2; ++ai)
#pragma unroll
                    for (int m = 0; m < 4; ++m) { const f32x4_t v = acc[ai][bj][m][n]; u32x4_t k;
                        k.x = (f2key(v[0]) & ~127u) | ib; k.y = (f2key(v[1]) & ~127u) | (ib - 1u); k.z = (f2key(v[2]) & ~127u) | (ib - 2u); k.w = (f2key(v[3]) & ~127u) | (ib - 3u);
                        *(u32x4_t*)(skey + (size_t)(row0 + ai * 128 + m * 16) * 2048 + c) = k; } }
    }
};

#if NAIVE_GEMM
template <class Epi> __device__ __forceinline__ void gemm_naive(const pg8::Gemm g, int G, int c, const Epi& E) {
    const int tid = threadIdx.x, wid = tid >> 6, lane = tid & 63, wr = wid >> 2, wc = wid & 3, fr = lane & 15, fq = lane >> 4;
    pg8::StaticOrder S; S.init(g.M, g.N, G, c); pg8::Unit u;
    for (int ui = 0; S.next(ui, u); ++ui) {
        pg8::f32x4 acc[2][2][4][2];
#pragma unroll 1
        for (int ai = 0; ai < 2; ++ai)
#pragma unroll 1
            for (int bj = 0; bj < 2; ++bj) {
                float a4[4][2][4];
#pragma unroll
                for (int m = 0; m < 4; ++m) for (int n = 0; n < 2; ++n) for (int j = 0; j < 4; ++j) a4[m][n][j] = 0.f;
                const bf16_t* Ar[4]; const bf16_t* Br[2][4];
#pragma unroll
                for (int m = 0; m < 4; ++m) Ar[m] = g.A + (size_t)(u.pm * 256 + ai * 128 + wr * 64 + m * 16 + fr) * g.K;
#pragma unroll
                for (int n = 0; n < 2; ++n) for (int j = 0; j < 4; ++j) { const int col = u.pn * 256 + bj * 128 + wc * 32 + (Epi::PERM ? 8 * fq + 4 * n + j : 16 * n + 4 * fq + j); Br[n][j] = g.Bt + (size_t)col * g.K; }
                for (int k = 0; k < g.K; k += 8) {
                    u32x4_t av[4], bv[2][4];
#pragma unroll
                    for (int m = 0; m < 4; ++m) av[m] = *(const u32x4_t*)(Ar[m] + k);
#pragma unroll
                    for (int n = 0; n < 2; ++n) for (int j = 0; j < 4; ++j) bv[n][j] = *(const u32x4_t*)(Br[n][j] + k);
#pragma unroll
                    for (int m = 0; m < 4; ++m)
#pragma unroll
                        for (int n = 0; n < 2; ++n)
#pragma unroll
                            for (int j = 0; j < 4; ++j) { float s = a4[m][n][j];
#pragma unroll
                                for (int q = 0; q < 4; ++q) { s += bflo(av[m][q]) * bflo(bv[n][j][q]); s += bfhi(av[m][q]) * bfhi(bv[n][j][q]); }
                                a4[m][n][j] = s; }
                }
#pragma unroll
                for (int m = 0; m < 4; ++m) for (int n = 0; n < 2; ++n) for (int j = 0; j < 4; ++j) acc[ai][bj][m][n][j] = a4[m][n][j];
            }
        E(acc, u, wr, wc, fr, fq);
    }
}
#endif

__device__ __forceinline__ void transpose_write(LAS float* scr, bf16_t* WT, int row_dst0, int K, int k0, int lane) {
    const int c = lane & 7;
#pragma unroll
    for (int j = 0; j < 4; ++j) { const int n = (lane >> 3) + 8 * j; const LAS float* s = scr + (8 * c) * 33 + n;
        u32x4_t o; o.x = pk2(s[0 * 33], s[1 * 33]); o.y = pk2(s[2 * 33], s[3 * 33]); o.z = pk2(s[4 * 33], s[5 * 33]); o.w = pk2(s[6 * 33], s[7 * 33]);
        *(u32x4_t*)(WT + (size_t)(row_dst0 + n) * K + k0 + 8 * c) = o; }
}
__device__ __forceinline__ void phase_prep(const Params& P, LAS unsigned char* lds, int vb, int G) {
    const int tid = threadIdx.x, lane = tid & 63, wave = tid >> 6;
    unsigned char* ws = P.ws;
    bf16_t* WTIN = (bf16_t*)(ws + WS_WTIN); bf16_t* WTOUT = (bf16_t*)(ws + WS_WTOUT); bf16_t* WTPK = (bf16_t*)(ws + WS_WTPK);
    float* MOD = (float*)(ws + WS_MOD);
    constexpr int I_PK = 256, I_MOD = 96, I_TR = 224, NITEMS = I_PK + I_MOD + I_TR;
    for (int it = vb; it < NITEMS; it += G) {
        __syncthreads();
        if (it < I_PK) {
            const int kb = it >> 4, g = it & 15, k0 = kb * 64;
            LAS float* A = (LAS float*)lds;
            LAS float* Kt = (LAS float*)(lds + 32768);
            const float* keys = (g & 1) ? P.peer_keys_2 : P.peer_keys_1;
#pragma unroll 4
            for (int i = 0; i < 16; ++i) { const int idx = i * 512 + tid, kk = idx >> 7, d = idx & 127; A[idx] = P.w_peer_q[(size_t)(k0 + kk) * 2048 + g * 128 + d]; }
#pragma unroll 4
            for (int i = 0; i < 32; ++i) { const int idx = i * 512 + tid, n = idx >> 7, d = idx & 127; Kt[d * 129 + n] = keys[idx]; }
            __syncthreads();
            const int n = tid & 127, ks = tid >> 7;
            float acc[16];
#pragma unroll
            for (int i = 0; i < 16; ++i) acc[i] = 0.f;
            for (int d = 0; d < 128; d += 4) {
                const float k0v = Kt[(d + 0) * 129 + n], k1v = Kt[(d + 1) * 129 + n], k2v = Kt[(d + 2) * 129 + n], k3v = Kt[(d + 3) * 129 + n];
#pragma unroll
                for (int i = 0; i < 16; ++i) { const f32x4_t a = *(const LAS f32x4_t*)(A + (ks * 16 + i) * 128 + d); acc[i] += a[0] * k0v + a[1] * k1v + a[2] * k2v + a[3] * k3v; }
            }
            u32x4_t o0, o1;
            o0.x = pk2(acc[0], acc[1]); o0.y = pk2(acc[2], acc[3]); o0.z = pk2(acc[4], acc[5]); o0.w = pk2(acc[6], acc[7]);
            o1.x = pk2(acc[8], acc[9]); o1.y = pk2(acc[10], acc[11]); o1.z = pk2(acc[12], acc[13]); o1.w = pk2(acc[14], acc[15]);
            bf16_t* dst = WTPK + (size_t)(g * 128 + n) * 1024 + k0 + ks * 16;
            *(u32x4_t*)dst = o0; *(u32x4_t*)(dst + 8) = o1;
        } else if (it < I_PK + I_MOD) {
            const int col = (it - I_PK) * 64 + lane;
            LAS float* cact = (LAS float*)lds;
            LAS float* red = (LAS float*)(lds + 16384);
#pragma unroll
            for (int i = 0; i < 8; ++i) { const int idx = i * 512 + tid; cact[idx] = silu_f(P.c[idx]); }
            __syncthreads();
            float a0 = 0.f, a1 = 0.f, a2 = 0.f, a3 = 0.f;
#pragma unroll 8
            for (int kk = 0; kk < 128; ++kk) { const int k = wave * 128 + kk; const float w = P.w_ada[(size_t)k * 6144 + col];
                a0 += cact[k] * w; a1 += cact[1024 + k] * w; a2 += cact[2048 + k] * w; a3 += cact[3072 + k] * w; }
            red[(wave * 4 + 0) * 64 + lane] = a0; red[(wave * 4 + 1) * 64 + lane] = a1; red[(wave * 4 + 2) * 64 + lane] = a2; red[(wave * 4 + 3) * 64 + lane] = a3;
            __syncthreads();
            if (tid < 256) { const int b = tid >> 6; float s = P.b_ada[col];
#pragma unroll
                for (int w = 0; w < 8; ++w) s += red[(w * 4 + b) * 64 + lane];
                MOD[b * 6144 + col] = s; }
        } else {
            const int wi = (it - I_PK - I_MOD) * 8 + wave;
            LAS float* scr = (LAS float*)(lds + wave * 8448);
            if (wi < 1152) { const int kb = wi / 72, nb = wi % 72, k0 = kb * 64, n0 = nb * 32, ns = n0 < 1024 ? n0 : n0 + 16;
#pragma unroll 8
                for (int i = 0; i < 32; ++i) { const int kk = 2 * i + (lane >> 5); scr[kk * 33 + (lane & 31)] = P.w_in[(size_t)(k0 + kk) * IN_W + ns + (lane & 31)]; }
                asm volatile("s_waitcnt lgkmcnt(0)" ::: "memory");
                transpose_write(scr, WTIN, n0, 1024, k0, lane);
            } else if (wi < 1664) { const int w2 = wi - 1152, kb = w2 / 32, nb = w2 % 32, k0 = kb * 64, n0 = nb * 32;
#pragma unroll 8
                for (int i = 0; i < 32; ++i) { const int kk = 2 * i + (lane >> 5); scr[kk * 33 + (lane & 31)] = P.w_out[(size_t)(k0 + kk) * 1024 + n0 + (lane & 31)]; }
                asm volatile("s_waitcnt lgkmcnt(0)" ::: "memory");
                transpose_write(scr, WTOUT, n0, 1024, k0, lane);
            } else { const int w2 = wi - 1664, kb = w2 / 8, nb = w2 % 8, k0 = kb * 64, n0 = nb * 32;
                for (int i = 0; i < 32; ++i) { const int kk = 2 * i + (lane >> 5); const float* wr_ = P.w_in + (size_t)(k0 + kk) * IN_W + 1024; float s = 0.f;
#pragma unroll
                    for (int r = 0; r < 16; ++r) s += wr_[r] * P.w_gla_alpha[r * 256 + n0 + (lane & 31)];
                    scr[kk * 33 + (lane & 31)] = s; }
                asm volatile("s_waitcnt lgkmcnt(0)" ::: "memory");
                transpose_write(scr, WTIN, 2304 + n0, 1024, k0, lane);
            }
            asm volatile("s_waitcnt lgkmcnt(0)" ::: "memory");
        }
    }
    {
        const size_t nchunk = (size_t)PEER_NE * DM / 8;
        bf16_t* UBF = (bf16_t*)(ws + WS_UBF); bf16_t* VBF = (bf16_t*)(ws + WS_VBF);
        for (size_t i = (size_t)vb * NTHREADS + tid; i < 2 * nchunk; i += (size_t)G * NTHREADS) {
            const bool second = i >= nchunk; const size_t j = second ? i - nchunk : i;
            const float* src = (second ? P.peer_v : P.peer_u) + j * 8; bf16_t* dst = (second ? VBF : UBF) + j * 8;
            const f32x4_t a = *(const f32x4_t*)src, b = *(const f32x4_t*)(src + 4);
            u32x4_t o; o.x = pk2(a[0], a[1]); o.y = pk2(a[2], a[3]); o.z = pk2(b[0], b[1]); o.w = pk2(b[2], b[3]);
            *(u32x4_t*)dst = o;
        }
    }
}

__device__ __forceinline__ void phase_normmod(const float* src, const float* gain, const float* mod, int shift_off, int scale_off, bf16_t* dst, int vb, int G) {
    const int tid = threadIdx.x, lane = tid & 63, wave = tid >> 6;
    for (int row = vb * NWAVES + wave; row < NT; row += G * NWAVES) {
        const float* xr = src + (size_t)row * DM; const float* mb = mod + (size_t)(row / SEQ) * 6144;
        f32x4_t v[4]; float s = 0.f;
#pragma unroll
        for (int j = 0; j < 4; ++j) { v[j] = *(const f32x4_t*)(xr + 4 * lane + 256 * j); s += v[j][0] * v[j][0] + v[j][1] * v[j][1] + v[j][2] * v[j][2] + v[j][3] * v[j][3]; }
        const float rstd = rsqrtf(wave_sum(s) * (1.f / DM) + RMS_EPS);
#pragma unroll
        for (int j = 0; j < 4; ++j) { const int c = 4 * lane + 256 * j;
            const f32x4_t g = *(const f32x4_t*)(gain + c), sh = *(const f32x4_t*)(mb + shift_off + c), sc = *(const f32x4_t*)(mb + scale_off + c);
            const f32x4_t h = (v[j] * rstd) * g * (sc + 1.f) + sh;
            u32x2_t o; o.x = pk2(h[0], h[1]); o.y = pk2(h[2], h[3]);
            *(u32x2_t*)(dst + (size_t)row * DM + c) = o; }
    }
}

#if NAIVE_GLA
__device__ __forceinline__ void phase_gla_naive(const Params& P, float* ogla, int vb, int G) {
    const int tid = threadIdx.x, lane = tid & 63, wave = tid >> 6;
    const bf16_t* PROJ = (const bf16_t*)(P.ws + WS_PROJ); const float* LOGA = (const float*)(P.ws + WS_LOGA);
    for (int it = vb; it < NB * GLA_H * 4; it += G) {
        const int b = it >> 4, h = (it >> 2) & 3, sl = it & 3, dv0 = sl * 32 + wave * 4;
        float S0 = 0.f, S1 = 0.f, S2 = 0.f, S3 = 0.f;
#pragma unroll 4
        for (int t = 0; t < SEQ; ++t) {
            const size_t row = (size_t)b * SEQ + t; const bf16_t* pr = PROJ + row * PROJ_W;
            const float a = __expf(LOGA[row * 256 + h * 64 + lane]);
            const float kk = bf2f(pr[C_KG + h * 64 + lane]), q = bf2f(pr[C_QG + h * 64 + lane]);
            const u32x2_t vv = *(const u32x2_t*)(pr + C_VG + h * 128 + dv0);
            S0 = a * S0 + kk * bflo(vv.x); S1 = a * S1 + kk * bfhi(vv.x); S2 = a * S2 + kk * bflo(vv.y); S3 = a * S3 + kk * bfhi(vv.y);
            const float o0 = wave_sum(q * S0), o1 = wave_sum(q * S1), o2 = wave_sum(q * S2), o3 = wave_sum(q * S3);
            if (lane == 0) { f32x4_t o = {o0, o1, o2, o3}; *(f32x4_t*)(ogla + row * 512 + h * 128 + dv0) = o; }
        }
    }
}
#endif
#if NAIVE_SWA
__device__ __forceinline__ void phase_swa_naive(const Params& P, float* oswa, int vb, int G) {
    const bf16_t* PROJ = (const bf16_t*)(P.ws + WS_PROJ);
    for (int idx = vb * NTHREADS + threadIdx.x; idx < NT * SWA_H; idx += G * NTHREADS) {
        const int row = idx >> 3, head = idx & 7, kvh = head >> 2, t = row % SEQ, b = row / SEQ;
        const float slope = exp2f(-(float)(head + 1)), sink = P.swa_sinks[head];
        float q[64], acc[64];
        const bf16_t* qp = PROJ + (size_t)row * PROJ_W + C_QS + head * 64;
#pragma unroll
        for (int d = 0; d < 64; d += 8) { const u32x4_t w = *(const u32x4_t*)(qp + d);
#pragma unroll
            for (int j = 0; j < 4; ++j) { q[d + 2 * j] = bflo(w[j]); q[d + 2 * j + 1] = bfhi(w[j]); } }
#pragma unroll
        for (int d = 0; d < 64; ++d) acc[d] = 0.f;
        float m = sink, l = 1.f;
        const int s0 = t - (SWA_W - 1) < 0 ? 0 : t - (SWA_W - 1);
        for (int s = s0; s <= t; ++s) {
            const bf16_t* kp = PROJ + (size_t)(b * SEQ + s) * PROJ_W + C_KS + kvh * 64; const bf16_t* vp = kp + (C_VS - C_KS);
            float dot = 0.f;
#pragma unroll
            for (int d = 0; d < 64; d += 8) { const u32x4_t w = *(const u32x4_t*)(kp + d);
#pragma unroll
                for (int j = 0; j < 4; ++j) { dot += q[d + 2 * j] * bflo(w[j]); dot += q[d + 2 * j + 1] * bfhi(w[j]); } }
            const float sc = dot - slope * (float)(t - s);
            const float mn = fmaxf(m, sc), f = __expf(m - mn), p = __expf(sc - mn);
            l = l * f + p; m = mn;
#pragma unroll
            for (int d = 0; d < 64; d += 8) { const u32x4_t w = *(const u32x4_t*)(vp + d);
#pragma unroll
                for (int j = 0; j < 4; ++j) { acc[d + 2 * j] = acc[d + 2 * j] * f + p * bflo(w[j]); acc[d + 2 * j + 1] = acc[d + 2 * j + 1] * f + p * bfhi(w[j]); } }
        }
        const float rl = 1.f / l; float* op = oswa + (size_t)row * 512 + head * 64;
#pragma unroll
        for (int d = 0; d < 64; d += 4) { f32x4_t o = {acc[d] * rl, acc[d + 1] * rl, acc[d + 2] * rl, acc[d + 3] * rl}; *(f32x4_t*)(op + d) = o; }
    }
}
#endif
__device__ __forceinline__ void phase_mixnorm(const Params& P, const float* ogla, const float* oswa, int do_gla, int do_swa, int vb, int G) {
    const int tid = threadIdx.x, lane = tid & 63, wave = tid >> 6;
    const bf16_t* PROJ = (const bf16_t*)(P.ws + WS_PROJ); bf16_t* OMIX = (bf16_t*)(P.ws + WS_OMIX);
    for (int row = vb * NWAVES + wave; row < NT; row += G * NWAVES) {
        const int c = lane * 8;
        if (do_gla) {
            const f32x4_t a = *(const f32x4_t*)(ogla + (size_t)row * 512 + c), b = *(const f32x4_t*)(ogla + (size_t)row * 512 + c + 4);
            float s = a[0] * a[0] + a[1] * a[1] + a[2] * a[2] + a[3] * a[3] + b[0] * b[0] + b[1] * b[1] + b[2] * b[2] + b[3] * b[3];
            s += __shfl_xor(s, 1); s += __shfl_xor(s, 2); s += __shfl_xor(s, 4); s += __shfl_xor(s, 8);
            const float rstd = rsqrtf(s * (1.f / GLA_DV) + RMS_EPS);
            const f32x4_t g0 = *(const f32x4_t*)(P.gla_norm_g + c), g1 = *(const f32x4_t*)(P.gla_norm_g + c + 4);
            const u32x4_t rw = *(const u32x4_t*)(PROJ + (size_t)row * PROJ_W + C_RG + c);
            float o[8];
#pragma unroll
            for (int j = 0; j < 4; ++j) { o[j] = a[j] * rstd * g0[j]; o[4 + j] = b[j] * rstd * g1[j]; }
#pragma unroll
            for (int j = 0; j < 4; ++j) { o[2 * j] *= silu_f(bflo(rw[j])); o[2 * j + 1] *= silu_f(bfhi(rw[j])); }
            u32x4_t w; w.x = pk2(o[0], o[1]); w.y = pk2(o[2], o[3]); w.z = pk2(o[4], o[5]); w.w = pk2(o[6], o[7]);
            *(u32x4_t*)(OMIX + (size_t)row * DM + c) = w;
        }
        if (do_swa) {
            const f32x4_t a = *(const f32x4_t*)(oswa + (size_t)row * 512 + c), b = *(const f32x4_t*)(oswa + (size_t)row * 512 + c + 4);
            float s = a[0] * a[0] + a[1] * a[1] + a[2] * a[2] + a[3] * a[3] + b[0] * b[0] + b[1] * b[1] + b[2] * b[2] + b[3] * b[3];
            const float rstd = rsqrtf(wave_sum(s) * (1.f / 512.f) + RMS_EPS);
            const f32x4_t g0 = *(const f32x4_t*)(P.swa_norm_g + c), g1 = *(const f32x4_t*)(P.swa_norm_g + c + 4);
            u32x4_t w; w.x = pk2(a[0] * rstd * g0[0], a[1] * rstd * g0[1]); w.y = pk2(a[2] * rstd * g0[2], a[3] * rstd * g0[3]);
            w.z = pk2(b[0] * rstd * g1[0], b[1] * rstd * g1[1]); w.w = pk2(b[2] * rstd * g1[2], b[3] * rstd * g1[3]);
            *(u32x4_t*)(OMIX + (size_t)row * DM + 512 + c) = w;
        }
    }
}

constexpr int PEER_WLDS = 9216 + 1024 + 4096;
__device__ __forceinline__ void insert16(unsigned (&L)[16], unsigned x) {
#pragma unroll
    for (int j = 0; j < 16; ++j) { const unsigned hi = L[j] > x ? L[j] : x; x = L[j] > x ? x : L[j]; L[j] = hi; }
}
__device__ __forceinline__ void phase_peer(const Params& P, LAS unsigned char* lds, int vb, int G) {
    const int tid = threadIdx.x, lane = tid & 63, wave = tid >> 6;
    const unsigned* SKEY = (const unsigned*)(P.ws + WS_SKEY); const bf16_t* H2 = (const bf16_t*)(P.ws + WS_H);
    const bf16_t* UBF = (const bf16_t*)(P.ws + WS_UBF); const bf16_t* VBF = (const bf16_t*)(P.ws + WS_VBF); const float* MOD = (const float*)(P.ws + WS_MOD);
    LAS unsigned* stage = (LAS unsigned*)(lds + wave * PEER_WLDS);
    LAS unsigned char* idxb = (LAS unsigned char*)(lds + wave * PEER_WLDS + 9216);
    LAS unsigned* eg = (LAS unsigned*)(lds + wave * PEER_WLDS + 9216 + 1024);
    for (int quad = vb * NWAVES + wave; quad < NT / 4; quad += G * NWAVES) {
        const int t0 = quad * 4;
        unsigned L[16];
#pragma unroll
        for (int j = 0; j < 16; ++j) L[j] = 0u;
        for (int p = 0; p < 4; ++p) {
            asm volatile("s_waitcnt lgkmcnt(0)" ::: "memory");
#pragma unroll
            for (int i = 0; i < 8; ++i) { const int seg = i * 8 + (lane >> 3), ch = lane & 7;
                const u32x4_t v = *(const u32x4_t*)(SKEY + (size_t)(t0 + (seg >> 4)) * 2048 + (seg & 15) * 128 + p * 32 + ch * 4);
                *(LAS u32x4_t*)(stage + seg * 36 + ch * 4) = v; }
            asm volatile("s_waitcnt lgkmcnt(0)" ::: "memory");
#pragma unroll
            for (int cch = 0; cch < 8; ++cch) { const u32x4_t v = *(const LAS u32x4_t*)(stage + lane * 36 + cch * 4);
                insert16(L, v.x); insert16(L, v.y); insert16(L, v.z); insert16(L, v.w); }
        }
#pragma unroll
        for (int j = 0; j < 4; ++j) { unsigned w = 0;
#pragma unroll
            for (int q = 0; q < 4; ++q) w |= (127u - (L[4 * j + q] & 127u)) << (8 * q);
            *(LAS unsigned*)(idxb + lane * 16 + 4 * j) = w; }
        float v1[16], v2[16];
        { const bool odd = lane & 1;
#pragma unroll
          for (int j = 0; j < 16; ++j) { const float mine = key2f(L[j] & ~127u); const float oth = __shfl_xor(mine, 1); v1[j] = odd ? oth : mine; v2[j] = odd ? mine : oth; } }
        unsigned C[16];
#pragma unroll
        for (int j = 0; j < 16; ++j) C[j] = 0u;
#pragma unroll
        for (int i = 0; i < 16; ++i)
#pragma unroll
            for (int j = 0; j < 16; ++j) if ((i + 1) * (j + 1) <= 16) insert16(C, (f2key(v1[i] + v2[j]) & ~255u) | (255u - (unsigned)(i * 16 + j)));
        asm volatile("s_waitcnt lgkmcnt(0)" ::: "memory");
        {
            const float mx = key2f(C[0] & ~255u); float e[16], se = 0.f;
#pragma unroll
            for (int j = 0; j < 16; ++j) { e[j] = __expf(key2f(C[j] & ~255u) - mx); se += e[j]; }
            const float rs = 1.f / se;
            if (!(lane & 1)) { const int tok = lane >> 4, head = (lane & 15) >> 1;
#pragma unroll
                for (int j = 0; j < 16; ++j) { const unsigned code = 255u - (C[j] & 255u); const unsigned e1 = idxb[lane * 16 + (code >> 4)], e2 = idxb[(lane + 1) * 16 + (code & 15u)];
                    u32x2_t o; o.x = e1 * 128u + e2; o.y = __float_as_uint(e[j] * rs);
                    *(LAS u32x2_t*)(eg + (tok * 128 + head * 16 + j) * 2) = o; } }
        }
        asm volatile("s_waitcnt lgkmcnt(0)" ::: "memory");
        for (int tk = 0; tk < 4; ++tk) {
            const size_t row = (size_t)(t0 + tk);
            float hf[16], acc[16];
            { const u32x4_t a = *(const u32x4_t*)(H2 + row * DM + lane * 8), b = *(const u32x4_t*)(H2 + row * DM + 512 + lane * 8);
#pragma unroll
              for (int j = 0; j < 4; ++j) { hf[2 * j] = bflo(a[j]); hf[2 * j + 1] = bfhi(a[j]); hf[8 + 2 * j] = bflo(b[j]); hf[8 + 2 * j + 1] = bfhi(b[j]); } }
#pragma unroll
            for (int j = 0; j < 16; ++j) acc[j] = 0.f;
            for (int e0 = 0; e0 < 128; e0 += 8) {
                u32x4_t ur[8][2], vr[8][2]; float gt[8];
#pragma unroll
                for (int k = 0; k < 8; ++k) { const u32x2_t ev = *(const LAS u32x2_t*)(eg + (tk * 128 + e0 + k) * 2);
                    const unsigned eid = __builtin_amdgcn_readfirstlane(ev.x); gt[k] = __uint_as_float(__builtin_amdgcn_readfirstlane(ev.y));
                    const bf16_t* up = UBF + (size_t)eid * DM + lane * 8; const bf16_t* vp = VBF + (size_t)eid * DM + lane * 8;
                    ur[k][0] = *(const u32x4_t*)up; ur[k][1] = *(const u32x4_t*)(up + 512); vr[k][0] = *(const u32x4_t*)vp; vr[k][1] = *(const u32x4_t*)(vp + 512); }
#pragma unroll
                for (int k = 0; k < 8; ++k) { float d = 0.f;
#pragma unroll
                    for (int j = 0; j < 4; ++j) { d += hf[2 * j] * bflo(ur[k][0][j]); d += hf[2 * j + 1] * bfhi(ur[k][0][j]); d += hf[8 + 2 * j] * bflo(ur[k][1][j]); d += hf[8 + 2 * j + 1] * bfhi(ur[k][1][j]); }
                    const float a = wave_sum(d); const float w = gt[k] * 0.5f * a * (1.f + erff(a * 0.70710678118654752f));
#pragma unroll
                    for (int j = 0; j < 4; ++j) { acc[2 * j] += w * bflo(vr[k][0][j]); acc[2 * j + 1] += w * bfhi(vr[k][0][j]); acc[8 + 2 * j] += w * bflo(vr[k][1][j]); acc[8 + 2 * j + 1] += w * bfhi(vr[k][1][j]); } }
            }
            const float* g2 = MOD + (size_t)(row / SEQ) * 6144 + 5120; float* xr = P.out + row * DM;
            float x2[16]; float s = 0.f;
#pragma unroll
            for (int hh = 0; hh < 2; ++hh)
#pragma unroll
                for (int q = 0; q < 2; ++q) { const int c = hh * 512 + lane * 8 + q * 4; const f32x4_t xv = *(const f32x4_t*)(xr + c), gv = *(const f32x4_t*)(g2 + c);
#pragma unroll
                    for (int j = 0; j < 4; ++j) { const float v = xv[j] + gv[j] * acc[hh * 8 + q * 4 + j]; x2[hh * 8 + q * 4 + j] = v; s += v * v; } }
            const float rstd = rsqrtf(wave_sum(s) * (1.f / DM) + RMS_EPS);
#pragma unroll
            for (int hh = 0; hh < 2; ++hh)
#pragma unroll
                for (int q = 0; q < 2; ++q) { const int c = hh * 512 + lane * 8 + q * 4; const f32x4_t fg = *(const f32x4_t*)(P.final_g + c); f32x4_t o;
#pragma unroll
                    for (int j = 0; j < 4; ++j) o[j] = x2[hh * 8 + q * 4 + j] * rstd * fg[j];
                    *(f32x4_t*)(xr + c) = o; }
        }
    }
}

constexpr int LDS_BYTES = 147456;
struct Args { Params p; int phase; int pad; };

template <class Epi> __device__ __forceinline__ void run_gemm(LAS unsigned char* lds, const bf16_t* A, const bf16_t* Bt, int N, const Epi& E) {
    pg8::Gemm g{A, Bt, NT, N, DM};
#if NAIVE_GEMM
    gemm_naive<Epi>(g, (int)gridDim.x, (int)blockIdx.x, E);
#else
    pg8::StaticOrder S; S.init(NT, N, (int)gridDim.x, (int)blockIdx.x);
    pg8::gemm_phase<Epi, pg8::StaticOrder, true, true>(lds, g, S, E);
#endif
}

template <int PH> __global__ void __launch_bounds__(NTHREADS, 2) fwd_kernel(Args a) {
    extern __shared__ __attribute__((aligned(16))) unsigned char smem[];
    LAS unsigned char* lds = (LAS unsigned char*)smem;
    const Params& P = a.p; unsigned char* ws = P.ws;
    const int vb = blockIdx.x, G = gridDim.x;
    const float* MOD = (const float*)(ws + WS_MOD);
    float* ogla = P.out; float* oswa = P.out + (size_t)NT * 512;
    switch (PH) {
    case 0: phase_prep(P, lds, vb, G); break;
    case 1: phase_normmod(P.x, P.norm1_g, MOD, 0, 1024, (bf16_t*)(ws + WS_H), vb, G); break;
    case 2: { EpiProj E{(bf16_t*)(ws + WS_PROJ), (float*)(ws + WS_LOGA), P.b_gla_alpha}; run_gemm(lds, (const bf16_t*)(ws + WS_H), (const bf16_t*)(ws + WS_WTIN), NPAD, E); } break;
#if NAIVE_GLA
    case 3: phase_gla_naive(P, ogla, vb, G); break;
#endif
#if NAIVE_SWA
    case 4: phase_swa_naive(P, oswa, vb, G); break;
#endif
    case 5: phase_mixnorm(P, ogla, oswa, NAIVE_GLA, NAIVE_SWA, vb, G); break;
    case 6: { EpiOut E{P.x, MOD, P.out}; run_gemm(lds, (const bf16_t*)(ws + WS_OMIX), (const bf16_t*)(ws + WS_WTOUT), DM, E); } break;
    case 7: phase_normmod(P.out, P.norm2_g, MOD, 3072, 4096, (bf16_t*)(ws + WS_H), vb, G); break;
    case 8: { EpiKey E{(unsigned*)(ws + WS_SKEY)}; run_gemm(lds, (const bf16_t*)(ws + WS_H), (const bf16_t*)(ws + WS_WTPK), 2048, E); } break;
    case 9: phase_peer(P, lds, vb, G); break;
    default: break;
    }
}

extern "C" void kernel_launch(void* const* d_in, const int* in_sizes, int n_in, void* d_out, int out_size, void* d_ws, size_t ws_size, hipStream_t stream) {
    static int ready = 0;
    if (ready == 0) {
        if (n_in != 19 || out_size != NT * DM || ws_size < WS_END) { fprintf(stderr, "kernel_launch: unexpected sizes n_in %d out %d ws %zu\n", n_in, out_size, ws_size); ready = -1; return; }
#define SETATTR(PH) if (hipFuncSetAttribute((const void*)fwd_kernel<PH>, hipFuncAttributeMaxDynamicSharedMemorySize, LDS_BYTES) != hipSuccess) { fprintf(stderr, "kernel_launch: hipFuncSetAttribute failed\n"); ready = -1; return; }
        SETATTR(0) SETATTR(1) SETATTR(2) SETATTR(3) SETATTR(4) SETATTR(5) SETATTR(6) SETATTR(7) SETATTR(8) SETATTR(9)
        ready = 1;
    }
    if (ready < 0) return;
    Args a{};
    const float** pp = (const float**)&a.p;
    for (int i = 0; i < 19; ++i) pp[i] = (const float*)d_in[i];
    a.p.out = (float*)d_out; a.p.ws = (unsigned char*)d_ws;
#define LAUNCH(PH) hipLaunchKernelGGL(fwd_kernel<PH>, dim3(256), dim3(NTHREADS), LDS_BYTES, stream, a);
    LAUNCH(0) LAUNCH(1) LAUNCH(2) LAUNCH(3) LAUNCH(4) LAUNCH(5) LAUNCH(6) LAUNCH(7) LAUNCH(8) LAUNCH(9)
}
```

```cpp
#include <hip/hip_runtime.h>
#include <cstdio>
#include <cstdint>
#include <cmath>

constexpr int DM = 1024, NB = 4, SEQ = 8192, NT = NB * SEQ;
constexpr int GLA_H = 4, GLA_DK = 64, GLA_DV = 128, GLA_RANK = 16, GLA_CHUNK = 64;
constexpr int SWA_H = 8, SWA_KV = 2, SWA_HD = 64, SWA_W = 128;
constexpr int PEER_H = 8, PEER_NK = 128, PEER_NE = PEER_NK * PEER_NK, PEER_QD = 256, PEER_K = 16;
constexpr int IN_W = 2320;
constexpr float RMS_EPS = 1e-6f;
constexpr int PROJ_W = 2304, NPAD = 2560;
constexpr int C_QG = 0, C_KG = 256, C_VG = 512, C_RG = 1024, C_QS = 1536, C_KS = 2048, C_VS = 2176;
constexpr int NTHREADS = 512, NWAVES = 8;
constexpr int LDS_BYTES = 163840;
constexpr int MISC_OFF = LDS_BYTES - 512;

constexpr size_t MiB = 1u << 20;
constexpr size_t WS_CTL = 0, CTL_ZERO_BYTES = 64 * 1024;
constexpr size_t WS_MOD = 1 * MiB;
constexpr size_t WS_WTIN = 2 * MiB;
constexpr size_t WS_WTOUT = 7 * MiB;
constexpr size_t WS_WTPK = 9 * MiB;
constexpr size_t WS_GU = 13 * MiB;
constexpr size_t WS_GD = 21 * MiB;
constexpr size_t WS_USC = 21 * MiB + 256 * 1024, WS_VSC = WS_USC + 65536;
constexpr size_t WS_UBF = 22 * MiB;
constexpr size_t WS_VBF = 54 * MiB;
constexpr size_t WS_H = 86 * MiB;
constexpr size_t WS_PROJ = 150 * MiB;
constexpr size_t WS_LOGA = 294 * MiB;
constexpr size_t WS_OMIX = 326 * MiB;
constexpr size_t WS_SKEY = 150 * MiB;
constexpr size_t WS_X1 = 406 * MiB;
constexpr size_t WS_WPF = 470 * MiB;
constexpr size_t WS_WTPKB = 478 * MiB;
constexpr size_t WS_CB = 1 * MiB + 128 * 1024;
constexpr size_t WS_SSQ2 = 38 * MiB;
constexpr size_t WS_END = 494 * MiB;

typedef unsigned short bf16_t;
typedef unsigned u32x4_t __attribute__((ext_vector_type(4)));
typedef unsigned u32x2_t __attribute__((ext_vector_type(2)));
typedef float f32x4_t __attribute__((ext_vector_type(4)));
#define LAS __attribute__((address_space(3)))
#define GAS __attribute__((address_space(1)))

struct Params {
    const float *x, *c, *w_ada, *b_ada, *norm1_g, *norm2_g, *w_in, *w_gla_alpha, *b_gla_alpha, *gla_norm_g, *swa_sinks, *swa_norm_g, *w_out, *w_peer_q,
        *peer_keys_1, *peer_keys_2, *peer_u, *peer_v, *final_g;
    float* out; unsigned char* ws;
};

__device__ __forceinline__ float bf2f(unsigned v) { return __uint_as_float(v << 16); }
__device__ __forceinline__ float bflo(unsigned w) { return __uint_as_float(w << 16); }
__device__ __forceinline__ float bfhi(unsigned w) { return __uint_as_float(w & 0xffff0000u); }
typedef float f32x2_t __attribute__((ext_vector_type(2))); typedef __bf16 bf16x2_t __attribute__((ext_vector_type(2)));
__device__ __forceinline__ unsigned pk2(float lo, float hi) { const f32x2_t v = {lo, hi}; return __builtin_bit_cast(unsigned, __builtin_convertvector(v, bf16x2_t)); }
__device__ __forceinline__ unsigned f2bf(float f) { return pk2(f, 0.f) & 0xffffu; }
__device__ __forceinline__ float wave_sum(float v) {
#pragma unroll
    for (int o = 1; o < 64; o <<= 1) v += __shfl_xor(v, o);
    return v;
}
__device__ __forceinline__ float silu_f(float v) { return v / (1.f + __expf(-v)); }
__device__ __forceinline__ unsigned f2key(float f) { unsigned u = __float_as_uint(f); return u ^ ((u >> 31) ? 0xffffffffu : 0x80000000u); }
__device__ __forceinline__ float key2f(unsigned k) { unsigned u = k ^ ((k >> 31) ? 0x80000000u : 0xffffffffu); return __uint_as_float(u); }

__device__ __forceinline__ int opaque_tid() { int t = threadIdx.x; asm volatile("" : "+v"(t)); return t; }
__device__ __forceinline__ void insert16(unsigned (&L)[16], unsigned x) {
#pragma unroll
    for (int j = 0; j < 16; ++j) { const unsigned hi = L[j] > x ? L[j] : x; x = L[j] > x ? x : L[j]; L[j] = hi; }
}
__device__ __forceinline__ void cex(unsigned& a, unsigned& b) { const unsigned hi = a > b ? a : b, lo = a > b ? b : a; a = hi; b = lo; }
__device__ __forceinline__ void bitonic_merge16(unsigned (&v)[16]) {
#pragma unroll
    for (int j = 8; j >= 1; j >>= 1)
#pragma unroll
        for (int i = 0; i < 16; ++i) if ((i & j) == 0) cex(v[i], v[i | j]);
}
__device__ __forceinline__ void sort16_desc(unsigned (&v)[16]) {
#pragma unroll
    for (int k = 2; k <= 16; k <<= 1)
#pragma unroll
        for (int j = k >> 1; j >= 1; j >>= 1)
#pragma unroll
            for (int i = 0; i < 16; ++i) { const int l = i ^ j; if (l > i) { if ((i & k) == 0 || k == 16) cex(v[i], v[l]); else cex(v[l], v[i]); } }
}
__device__ __forceinline__ void merge_top16(unsigned (&L)[16], const unsigned (&N)[16]) {
#pragma unroll
    for (int i = 0; i < 16; ++i) L[i] = L[i] > N[15 - i] ? L[i] : N[15 - i];
    bitonic_merge16(L);
}
__device__ __forceinline__ int row_sum16_i(int v) {
    v += __builtin_amdgcn_mov_dpp(v, 0x128, 0xf, 0xf, false); v += __builtin_amdgcn_mov_dpp(v, 0x124, 0xf, 0xf, false);
    v += __builtin_amdgcn_mov_dpp(v, 0x122, 0xf, 0xf, false); v += __builtin_amdgcn_mov_dpp(v, 0x121, 0xf, 0xf, false); return v;
}
__device__ __forceinline__ float row_sum16_f(float v) {
    v += __builtin_bit_cast(float, __builtin_amdgcn_mov_dpp(__builtin_bit_cast(int, v), 0x128, 0xf, 0xf, false)); v += __builtin_bit_cast(float, __builtin_amdgcn_mov_dpp(__builtin_bit_cast(int, v), 0x124, 0xf, 0xf, false));
    v += __builtin_bit_cast(float, __builtin_amdgcn_mov_dpp(__builtin_bit_cast(int, v), 0x122, 0xf, 0xf, false)); v += __builtin_bit_cast(float, __builtin_amdgcn_mov_dpp(__builtin_bit_cast(int, v), 0x121, 0xf, 0xf, false)); return v;
}
__device__ __forceinline__ float row_max16_f(float v) {
    v = fmaxf(v, __builtin_bit_cast(float, __builtin_amdgcn_mov_dpp(__builtin_bit_cast(int, v), 0x128, 0xf, 0xf, false))); v = fmaxf(v, __builtin_bit_cast(float, __builtin_amdgcn_mov_dpp(__builtin_bit_cast(int, v), 0x124, 0xf, 0xf, false)));
    v = fmaxf(v, __builtin_bit_cast(float, __builtin_amdgcn_mov_dpp(__builtin_bit_cast(int, v), 0x122, 0xf, 0xf, false))); v = fmaxf(v, __builtin_bit_cast(float, __builtin_amdgcn_mov_dpp(__builtin_bit_cast(int, v), 0x121, 0xf, 0xf, false))); return v;
}
__device__ __forceinline__ float dpp_swap1_f(float v) { return __builtin_bit_cast(float, __builtin_amdgcn_mov_dpp(__builtin_bit_cast(int, v), 0xB1, 0xf, 0xf, false)); }
__device__ __forceinline__ unsigned wave_incl_scan_u32(unsigned v) {
    v += (unsigned)__builtin_amdgcn_update_dpp(0, (int)v, 0x111, 0xf, 0xf, false); v += (unsigned)__builtin_amdgcn_update_dpp(0, (int)v, 0x112, 0xf, 0xf, false);
    v += (unsigned)__builtin_amdgcn_update_dpp(0, (int)v, 0x114, 0xf, 0xf, false); v += (unsigned)__builtin_amdgcn_update_dpp(0, (int)v, 0x118, 0xf, 0xf, false);
    v += (unsigned)__builtin_amdgcn_update_dpp(0, (int)v, 0x142, 0xa, 0xf, false); v += (unsigned)__builtin_amdgcn_update_dpp(0, (int)v, 0x143, 0xc, 0xf, false); return v;
}
__device__ __forceinline__ float row_ssq16(const float* p) {
    const f32x4_t a = *(const f32x4_t*)p, b = *(const f32x4_t*)(p + 4), c = *(const f32x4_t*)(p + 8), d = *(const f32x4_t*)(p + 12);
    return (((a[0] + a[1]) + (a[2] + a[3])) + ((b[0] + b[1]) + (b[2] + b[3]))) + (((c[0] + c[1]) + (c[2] + c[3])) + ((d[0] + d[1]) + (d[2] + d[3])));
}
namespace pg8 {
#define PG8_LAS __attribute__((address_space(3)))
typedef unsigned short bf16_t;
typedef short bf16x8 __attribute__((ext_vector_type(8)));
typedef float f32x4 __attribute__((ext_vector_type(4)));
typedef unsigned u32x4 __attribute__((ext_vector_type(4)));
constexpr int BM = 256, BK = 64, HALF = 128, HTB = HALF * BK * 2  , STAGE_BYTES = 8 * HTB, NXCD = 8, WGM = 8;

__host__ __device__ __forceinline__ int lds_byte(int r, int c) { const int st = (r >> 4) * 2 + (c >> 5), rr = r & 15, cc = c & 31, ob = rr * 64 + cc * 2; return st * 1024 + (ob ^ (((ob >> 9) & 1) << 5)); }
__host__ __device__ __forceinline__ void stage_rc(int b, int& R, int& C) { const int st = b / 1024, sb = b % 1024, swz = sb ^ (((sb >> 9) & 1) << 5); R = (st >> 1) * 16 + swz / 64; C = (st & 1) * 32 + (swz % 64) / 2; }
__host__ __device__ __forceinline__ int perm32(int rho) { const int n = rho >> 4, i = rho & 15; return 8 * (i >> 2) + 4 * n + (i & 3); }

struct Unit { int pm, pn; };
struct Gemm { const bf16_t* A; const bf16_t* Bt; int M, N, K; int bsel_tiles, bsel_pm; };

struct StaticOrder {
    int nM, nN, nwg, G, c;
    __host__ __device__ void init(int M, int N, int G_, int c_) { nM = M / BM; nN = N / BM; nwg = nM * nN; G = G_; c = c_; }
    __host__ __device__ bool next(int i, Unit& u) const {
        const long L = (long)i * G + c; if (L >= nwg) return false;
        int wgid = (int)L; { const int q = nwg / NXCD, r = nwg % NXCD, xcd = wgid % NXCD, off = wgid / NXCD; wgid = (xcd < r ? xcd * (q + 1) : r * (q + 1) + (xcd - r) * q) + off; }
        const int nig = WGM * nN, gid = wgid / nig, fm = gid * WGM, gsz = (nM - fm) < WGM ? (nM - fm) : WGM;
        u.pm = fm + ((wgid % nig) % gsz); u.pn = (wgid % nig) / gsz; return true;
    }
    __device__ __forceinline__ void a_ready(const Unit&) const {}
    __device__ __forceinline__ void done(const Unit&) const {}
};

__device__ __forceinline__ unsigned cvt_pk_bf16(float lo, float hi) { unsigned r; asm volatile("v_cvt_pk_bf16_f32 %0, %1, %2" : "=v"(r) : "v"(lo), "v"(hi)); return r; }
typedef float f32x2 __attribute__((ext_vector_type(2)));
template <class Epi, class Sched, bool ALIGN_EPI = false, bool SP2 = false>
__device__ __forceinline__ void gemm_phase(PG8_LAS unsigned char* lds, const Gemm g, const Sched& S, const Epi& E) {
    const int tid = opaque_tid(), wid = __builtin_amdgcn_readfirstlane(tid >> 6), lane = tid & 63, wr = wid >> 2, wc = wid & 3, fr = lane & 15, fq = lane >> 4;
    const int K = g.K, nt = K / BK;
    unsigned voffA[2], voffB[2];
#pragma unroll
    for (int i = 0; i < 2; ++i) { int R, C; stage_rc(tid * 16 + i * 8192, R, C); const int Rb = Epi::PERM ? ((R & ~31) + perm32(R & 31)) : R;
        voffA[i] = (unsigned)(R * K + C) * 2u; voffB[i] = (unsigned)(Rb * K + C) * 2u; }
    const size_t kstep = (size_t)(BK * 2);
    const size_t hstep = (size_t)HALF * K * 2;
    const size_t tstep = 2 * hstep;
    const unsigned ldsw = (unsigned)wid * 1024u;
    const int aoff = lds_byte(wr * 64 + fr, fq * 8), boff = lds_byte(wc * 32 + fr, fq * 8);
#define PG8_SA(b, h) (((b) * 2 + (h)) * HTB)
#define PG8_SB(b, h) ((4 + (b) * 2 + (h)) * HTB)
#define PG8_STAGE(bufoff, gbase, voff) do { _Pragma("unroll") for (int _i = 0; _i < 2; ++_i) \
        __builtin_amdgcn_global_load_lds((const unsigned*)((const char*)(gbase) + (voff)[_i]), (PG8_LAS unsigned*)(lds + (bufoff) + ldsw + _i * 8192), 16, 0, 0); } while (0)
#define PG8_LDA(dst, b, h) do { _Pragma("unroll") for (int m = 0; m < 4; ++m) _Pragma("unroll") for (int k = 0; k < 2; ++k) dst[m][k] = *(const PG8_LAS bf16x8*)(lds + PG8_SA(b, h) + aoff + m * 2048 + k * 1024); } while (0)
#define PG8_LDB(dst, b, h) do { _Pragma("unroll") for (int n = 0; n < 2; ++n) _Pragma("unroll") for (int k = 0; k < 2; ++k) dst[n][k] = *(const PG8_LAS bf16x8*)(lds + PG8_SB(b, h) + boff + n * 2048 + k * 1024); } while (0)
#define PG8_MMA(ai, bj, At, Bt) do { __builtin_amdgcn_s_setprio(1); _Pragma("unroll") for (int m = 0; m < 4; ++m) _Pragma("unroll") for (int n = 0; n < 2; ++n) _Pragma("unroll") for (int k = 0; k < 2; ++k) \
        acc[ai][bj][m][n] = __builtin_amdgcn_mfma_f32_16x16x32_bf16(Bt[n][k], At[m][k], acc[ai][bj][m][n], 0, 0, 0); __builtin_amdgcn_s_setprio(0); } while (0)
#define PG8_WAIT_V(n) asm volatile("s_waitcnt vmcnt(" #n ")" ::: "memory")
#define PG8_WAIT_L(n) asm volatile("s_waitcnt lgkmcnt(" #n ")" ::: "memory")
#define PG8_BAR __builtin_amdgcn_s_barrier()
#define PG8_SCHED __builtin_amdgcn_sched_barrier(0)
    Unit cur, nxt; int ui = 0;
    if (!S.next(0, cur)) return;
    f32x4 acc[2][2][4][2];
#pragma unroll
    for (int a = 0; a < 2; ++a)
#pragma unroll
        for (int b = 0; b < 2; ++b)
#pragma unroll
            for (int m = 0; m < 4; ++m)
#pragma unroll
                for (int n = 0; n < 2; ++n) acc[a][b][m][n] = (f32x4){0.f, 0.f, 0.f, 0.f};
    bf16x8 At[4][2], B0[2][2], B1[2][2];
    const char* cA = (const char*)g.A + (size_t)cur.pm * tstep; const char* cB = (const char*)g.Bt + (size_t)(cur.pn + (g.bsel_tiles ? g.bsel_tiles * (cur.pm / g.bsel_pm) : 0)) * tstep;
    S.a_ready(cur);
    if constexpr (SP2) {
        PG8_STAGE(PG8_SB(0, 0), cB, voffB); PG8_STAGE(PG8_SB(0, 1), cB + hstep, voffB); PG8_STAGE(PG8_SA(0, 0), cA, voffA); PG8_STAGE(PG8_SA(0, 1), cA + hstep, voffA);
        if (wr == 1) PG8_BAR;
        PG8_WAIT_V(2); PG8_BAR;
        PG8_STAGE(PG8_SB(1, 0), cB + kstep, voffB); PG8_STAGE(PG8_SA(1, 0), cA + kstep, voffA); PG8_STAGE(PG8_SB(1, 1), cB + hstep + kstep, voffB);
        PG8_WAIT_V(6); PG8_BAR;
    } else {
        PG8_STAGE(PG8_SB(0, 0), cB, voffB); PG8_STAGE(PG8_SA(0, 0), cA, voffA); PG8_STAGE(PG8_SB(0, 1), cB + hstep, voffB); PG8_STAGE(PG8_SA(0, 1), cA + hstep, voffA);
        if (wr == 1) PG8_BAR;
        PG8_WAIT_V(4); PG8_BAR;
        PG8_STAGE(PG8_SB(1, 0), cB + kstep, voffB); PG8_STAGE(PG8_SA(1, 0), cA + kstep, voffA); PG8_STAGE(PG8_SB(1, 1), cB + hstep + kstep, voffB);
        PG8_WAIT_V(6); PG8_BAR;
    }
    for (;;) {
        const bool has_next = S.next(ui + 1, nxt);
        const char* nA = has_next ? (const char*)g.A + (size_t)nxt.pm * tstep : cA; const char* nB = has_next ? (const char*)g.Bt + (size_t)(nxt.pn + (g.bsel_tiles ? g.bsel_tiles * (nxt.pm / g.bsel_pm) : 0)) * tstep : cB;
        for (int t = 0; t < nt; t += 2) {
            const bool last = (t == nt - 2);
            const char* a1 = cA + (size_t)(t + 1) * kstep;
            const char* a2 = last ? nA : cA + (size_t)(t + 2) * kstep; const char* b2 = last ? nB : cB + (size_t)(t + 2) * kstep;
            const char* a3 = a2 + kstep; const char* b3 = b2 + kstep;
            if (last && has_next) S.a_ready(nxt);
            if constexpr (SP2) {
            PG8_LDB(B0, 0, 0); PG8_LDB(B1, 0, 1); PG8_SCHED; PG8_LDA(At, 0, 0); PG8_STAGE(PG8_SA(1, 1), a1 + hstep, voffA);
            PG8_WAIT_V(8); PG8_WAIT_L(0); PG8_BAR; PG8_MMA(0, 0, At, B0); PG8_MMA(0, 1, At, B1); PG8_BAR; PG8_SCHED;
            PG8_LDA(At, 0, 1); PG8_STAGE(PG8_SB(0, 0), b2, voffB); PG8_STAGE(PG8_SB(0, 1), b2 + hstep, voffB); PG8_STAGE(PG8_SA(0, 0), a2, voffA);
            PG8_WAIT_V(8); PG8_WAIT_L(0); PG8_BAR; PG8_MMA(1, 0, At, B0); PG8_MMA(1, 1, At, B1); PG8_BAR; PG8_SCHED;
            PG8_LDB(B0, 1, 0); PG8_LDB(B1, 1, 1); PG8_SCHED; PG8_LDA(At, 1, 0); PG8_STAGE(PG8_SA(0, 1), a2 + hstep, voffA);
            PG8_WAIT_V(8); PG8_WAIT_L(0); PG8_BAR; PG8_MMA(0, 0, At, B0); PG8_MMA(0, 1, At, B1); PG8_BAR; PG8_SCHED;
            PG8_LDA(At, 1, 1); PG8_STAGE(PG8_SB(1, 0), b3, voffB); PG8_STAGE(PG8_SB(1, 1), b3 + hstep, voffB); PG8_STAGE(PG8_SA(1, 0), a3, voffA);
            PG8_WAIT_V(8); PG8_WAIT_L(0); PG8_BAR; PG8_MMA(1, 0, At, B0); PG8_MMA(1, 1, At, B1); PG8_BAR; PG8_SCHED;
            } else {
            PG8_LDB(B0, 0, 0); PG8_SCHED; PG8_LDA(At, 0, 0); PG8_STAGE(PG8_SA(1, 1), a1 + hstep, voffA);
            PG8_WAIT_L(8); PG8_BAR; PG8_WAIT_L(0); PG8_MMA(0, 0, At, B0); PG8_BAR; PG8_SCHED;
            PG8_LDB(B1, 0, 1); PG8_STAGE(PG8_SB(0, 0), b2, voffB);
            PG8_BAR; PG8_WAIT_L(0); PG8_MMA(0, 1, At, B1); PG8_BAR;
            PG8_LDA(At, 0, 1); PG8_STAGE(PG8_SA(0, 0), a2, voffA);
            PG8_BAR; PG8_WAIT_L(0); PG8_MMA(1, 0, At, B0); PG8_BAR; PG8_SCHED;
            PG8_STAGE(PG8_SB(0, 1), b2 + hstep, voffB);
            PG8_WAIT_V(6); PG8_BAR; PG8_MMA(1, 1, At, B1); PG8_BAR;
            PG8_LDB(B0, 1, 0); PG8_SCHED; PG8_LDA(At, 1, 0); PG8_STAGE(PG8_SA(0, 1), a2 + hstep, voffA);
            PG8_WAIT_L(8); PG8_BAR; PG8_WAIT_L(0); PG8_MMA(0, 0, At, B0); PG8_BAR; PG8_SCHED;
            PG8_LDB(B1, 1, 1); PG8_STAGE(PG8_SB(1, 0), b3, voffB);
            PG8_BAR; PG8_WAIT_L(0); PG8_MMA(0, 1, At, B1); PG8_BAR;
            PG8_LDA(At, 1, 1); PG8_STAGE(PG8_SA(1, 0), a3, voffA);
            PG8_BAR; PG8_WAIT_L(0); PG8_MMA(1, 0, At, B0); PG8_BAR; PG8_SCHED;
            PG8_STAGE(PG8_SB(1, 1), b3 + hstep, voffB);
            PG8_WAIT_V(6); PG8_BAR; PG8_MMA(1, 1, At, B1); PG8_BAR;
            }
        }
        if constexpr (ALIGN_EPI) { if (wr == 0) PG8_BAR; }
        if constexpr (!Epi::AFTER_DRAIN) { E(acc, cur, wr, wc, fr, fq); S.done(cur); }
        if (!has_next) break;
#pragma unroll
        for (int a = 0; a < 2; ++a)
#pragma unroll
            for (int b = 0; b < 2; ++b)
#pragma unroll
                for (int m = 0; m < 4; ++m)
#pragma unroll
                    for (int n = 0; n < 2; ++n) acc[a][b][m][n] = (f32x4){0.f, 0.f, 0.f, 0.f};
        cur = nxt; cA = nA; cB = nB; ++ui;
        if constexpr (ALIGN_EPI) { if (wr == 1) PG8_BAR; }
    }
    PG8_WAIT_V(0);
    if constexpr (!ALIGN_EPI) { if (wr == 0) PG8_BAR; }
    PG8_BAR;
    if constexpr (Epi::AFTER_DRAIN) { E.fused(acc, cur, wr, wc, fr, fq, lds, wid, lane); S.done(cur); }
#undef PG8_SA
#undef PG8_SB
#undef PG8_STAGE
#undef PG8_LDA
#undef PG8_LDB
#undef PG8_MMA
#undef PG8_WAIT_V
#undef PG8_WAIT_L
#undef PG8_BAR
#undef PG8_SCHED
}
}
typedef GAS unsigned gu32;
typedef GAS unsigned long long gu64;
#define RLX_AGENT __ATOMIC_RELAXED, __HIP_MEMORY_SCOPE_AGENT
#define LDS_WAIT() asm volatile("s_waitcnt lgkmcnt(0)" ::: "memory")
#define VM_WAIT() asm volatile("s_waitcnt vmcnt(0)" ::: "memory")
__device__ __forceinline__ unsigned long long rt() { return __builtin_amdgcn_s_memrealtime(); }
#define XB_TMO      128
#define XB_XCNT(j)  (256  + 64 * (j))
#define XB_XSUB(j)  (1280 + 64 * (j))
#define XB_XGEN(j)  (2304 + 64 * (j))
#define XB_TOP      3328
#define XB_TOPGEN   3392
#define XCD_BAR_WORDS 3456
#define XB_SPIN_CAP (1u << 18)

__device__ __forceinline__ unsigned xb_ld(unsigned* p)              { return __hip_atomic_load(p, __ATOMIC_RELAXED, __HIP_MEMORY_SCOPE_AGENT); }
__device__ __forceinline__ unsigned xb_add(unsigned* p, unsigned v) { return __hip_atomic_fetch_add(p, v, __ATOMIC_RELAXED, __HIP_MEMORY_SCOPE_AGENT); }
__device__ __forceinline__ unsigned xb_xcc_id() { return (unsigned)__builtin_amdgcn_s_getreg((3 << 11) | 20) & 0xFu; }
#define XB_SPIN(cond, bar) do { unsigned _sp = 0; while (cond) { __builtin_amdgcn_s_sleep(1); \
    if ((++_sp & 255u) == 0u) { if (xb_ld(&(bar)[XB_TMO])) break; if (_sp > XB_SPIN_CAP) { atomicAdd(&(bar)[XB_TMO], 1u); break; } } } } while (0)

struct XcdBarrier {
    unsigned* bar; unsigned x;
    volatile LAS unsigned* st;
};

__device__ __forceinline__ XcdBarrier xcd_barrier_post(unsigned* bar, volatile LAS unsigned* st) {
    XcdBarrier b; b.bar = bar; b.x = xb_xcc_id(); b.st = st;
    if (threadIdx.x == 0) (void)xb_add(&bar[XB_XCNT(b.x)], 1u);
    return b;
}
__device__ __forceinline__ void xcd_barrier_complete(unsigned* bar, unsigned x, unsigned& nloc, unsigned& nx) {
    const unsigned G = gridDim.x * gridDim.y * gridDim.z;
    unsigned sum, cnt, mine, sp = 0u;
    for (;;) {
        sum = 0u; cnt = 0u; mine = 0u;
#pragma unroll
        for (unsigned j = 0; j < 16; ++j) { const unsigned c = xb_ld(&bar[XB_XCNT(j)]); sum += c; cnt += (c > 0u) ? 1u : 0u; mine = (j == x) ? c : mine; }
        if (sum == G) break;
        __builtin_amdgcn_s_sleep(1);
        if ((++sp & 255u) == 0u) { if (xb_ld(&bar[XB_TMO])) break; if (sp > XB_SPIN_CAP) { atomicAdd(&bar[XB_TMO], 1u); break; } }
    }
    nloc = mine > 0u ? mine : 1u; nx = cnt > 0u ? cnt : 1u;
}

__device__ __forceinline__ void xcd_barrier(const XcdBarrier& b) {
    asm volatile("s_waitcnt vmcnt(0)" ::: "memory");
    __syncthreads();
    if (threadIdx.x == 0) {
        unsigned* bar = b.bar;
        __builtin_amdgcn_s_waitcnt(0);
        unsigned nloc = b.st[0], nx = b.st[1];
        if (nloc == 0u) { xcd_barrier_complete(bar, b.x, nloc, nx); b.st[0] = nloc; b.st[1] = nx; }
        const unsigned old = xb_add(&bar[XB_XSUB(b.x)], 1u);
        const unsigned gen = old / nloc;
        if (old + 1u == (gen + 1u) * nloc) {
            __builtin_amdgcn_fence(__ATOMIC_RELEASE, "agent");
            asm volatile("s_waitcnt vmcnt(0)" ::: "memory");
            const unsigned og = xb_add(&bar[XB_TOP], 1u);
            const unsigned tg = og / nx;
            if (og + 1u == (tg + 1u) * nx) xb_add(&bar[XB_TOPGEN], 1u);
            else XB_SPIN(xb_ld(&bar[XB_TOPGEN]) == tg, bar);
            __builtin_amdgcn_fence(__ATOMIC_ACQUIRE, "agent");
            xb_add(&bar[XB_XGEN(b.x)], 1u);
            asm volatile("s_waitcnt vmcnt(0)" ::: "memory");
        } else {
            XB_SPIN(xb_ld(&bar[XB_XGEN(b.x)]) == gen, bar);
            __builtin_amdgcn_fence(__ATOMIC_ACQUIRE, "agent");
            asm volatile("s_waitcnt vmcnt(0)" ::: "memory");
        }
    }
    __syncthreads();
}

typedef short bf16x8_t __attribute__((ext_vector_type(8)));
typedef short s16x4_t __attribute__((ext_vector_type(4)));
typedef float f32x16_t __attribute__((ext_vector_type(16)));
__device__ __forceinline__ s16x4_t lds_tr(const LAS unsigned char* p) { return __builtin_bit_cast(s16x4_t, __builtin_amdgcn_ds_read_tr16_b64_v4i16((LAS s16x4_t*)p)); }
__device__ __forceinline__ bf16x8_t cat8(s16x4_t lo, s16x4_t hi) { return (bf16x8_t){lo[0], lo[1], lo[2], lo[3], hi[0], hi[1], hi[2], hi[3]}; }
__device__ __forceinline__ void lds_st16(LAS unsigned char* p, float v) { *(LAS unsigned short*)p = (unsigned short)f2bf(v); }

constexpr int GL_QS = 0, GL_KS = 9216, GL_PS = 18432, GL_KH = 27648, GL_VS = 37888, GL_TOT = 56320, GL_DEC = 58368, GL_SSQ = 58624, GL_RSTD = 60672;
template <bool OUT> __device__ __forceinline__ void phase_gla(const Params& P, LAS unsigned char* lds, int vb, int G) {
    const int tid = opaque_tid(), lane = tid & 63, w = tid >> 6, n = lane & 15, g = lane >> 4, q_ = n >> 2, p_ = n & 3;
    const bf16_t* PROJ = (const bf16_t*)(P.ws + WS_PROJ); const float* LOGA = (const float*)(P.ws + WS_LOGA); bf16_t* OMIX = (bf16_t*)(P.ws + WS_OMIX);
    float* GU = (float*)(P.ws + WS_GU); float* GD = (float*)(P.ws + WS_GD);
    LAS float* TOT = (LAS float*)(lds + GL_TOT); LAS float* DEC = (LAS float*)(lds + GL_DEC); LAS float* SSQ = (LAS float*)(lds + GL_SSQ); LAS float* RSTD = (LAS float*)(lds + GL_RSTD);
    for (int item = vb; item < NB * GLA_H * 16; item += G) {
        const int b = item >> 6, h = (item >> 4) & 3, grp = item & 15; const size_t row0 = (size_t)b * SEQ + (size_t)grp * 512;
        f32x4_t S[4];
#pragma unroll
        for (int i = 0; i < 4; ++i) S[i] = (f32x4_t){0.f, 0.f, 0.f, 0.f};
        if (OUT) {
            for (int gp = 0; gp < grp; ++gp) { const float* U = GU + (size_t)(item - grp + gp) * 8192 + 16 * w + n; const float* Dv = GD + (size_t)(item - grp + gp) * 64;
#pragma unroll
                for (int i = 0; i < 4; ++i)
#pragma unroll
                    for (int r = 0; r < 4; ++r) { const int dk = 16 * i + 4 * g + r; S[i][r] = Dv[dk] * S[i][r] + U[dk * 128]; } }
        }
        float gdec = 1.f;
        const int ch = tid & 63, part = tid >> 6;
        float nla[8]; unsigned short nk[8], nq[8], nrg[16]; u32x4_t nv[2];
#define GLA_PREFETCH(rbase) do { const size_t rb_ = (rbase); \
            _Pragma("unroll") for (int i_ = 0; i_ < 8; ++i_) { const size_t row_ = rb_ + 8 * part + i_; nla[i_] = LOGA[row_ * 256 + h * 64 + ch]; nk[i_] = PROJ[row_ * PROJ_W + C_KG + h * 64 + ch]; if (OUT) nq[i_] = PROJ[row_ * PROJ_W + C_QG + h * 64 + ch]; } \
            _Pragma("unroll") for (int j_ = 0; j_ < 2; ++j_) { const int idx_ = tid + 512 * j_; nv[j_] = *(const u32x4_t*)(PROJ + (rb_ + (idx_ >> 4)) * PROJ_W + C_VG + h * 128 + (idx_ & 15) * 8); } \
            if (OUT) { _Pragma("unroll") for (int tl_ = 0; tl_ < 4; ++tl_) _Pragma("unroll") for (int r_ = 0; r_ < 4; ++r_) nrg[4 * tl_ + r_] = PROJ[(rb_ + 16 * tl_ + 4 * g + r_) * PROJ_W + C_RG + h * 128 + 16 * w + n]; } } while (0)
        GLA_PREFETCH(row0);
        for (int c = 0; c < 8; ++c) {
            const size_t r0 = row0 + (size_t)c * 64;
            __syncthreads();
            float pre[8]; unsigned short kraw[8], qraw[8], rgraw[16];
#pragma unroll
            for (int i = 0; i < 8; ++i) { pre[i] = nla[i]; kraw[i] = nk[i]; if (OUT) qraw[i] = nq[i]; }
            if (OUT) {
#pragma unroll
                for (int i = 0; i < 16; ++i) rgraw[i] = nrg[i]; }
#pragma unroll
            for (int j = 0; j < 2; ++j) { const int idx = tid + 512 * j, t = idx >> 4, cc = idx & 15; *(LAS u32x4_t*)(lds + GL_VS + t * 288 + cc * 16) = nv[j]; }
            if (c + 1 < 8) { GLA_PREFETCH(r0 + 64); }
#pragma unroll
            for (int i = 1; i < 8; ++i) pre[i] += pre[i - 1];
            TOT[part * 64 + ch] = pre[7];
            __syncthreads();
            float off = 0.f, blast = 0.f;
#pragma unroll
            for (int p = 0; p < 8; ++p) { const float tv = TOT[p * 64 + ch]; blast += tv; if (p < part) off += tv; }
#pragma unroll
            for (int i = 0; i < 8; ++i) { const int t = 8 * part + i; const float bt = off + pre[i], kf = bf2f(kraw[i]);
                lds_st16(lds + GL_KH + t * 160 + ch * 2, kf * __expf(blast - bt));
                if (OUT) { lds_st16(lds + GL_QS + t * 144 + ch * 2, bf2f(qraw[i]) * __expf(bt)); lds_st16(lds + GL_KS + t * 144 + ch * 2, kf * __expf(-bt)); } }
            if (part == 0) { const float d = __expf(blast); DEC[ch] = d; gdec *= d; }
            __syncthreads();
            if (OUT) {
                const int tr = w >> 1;
#pragma unroll
                for (int tcn = 0; tcn < 2; ++tcn) { const int tc = 2 * (w & 1) + tcn; f32x4_t acc = {0.f, 0.f, 0.f, 0.f};
                    if (tc <= tr) {
#pragma unroll
                        for (int s = 0; s < 2; ++s) { const bf16x8_t a = *(const LAS bf16x8_t*)(lds + GL_QS + (16 * tr + n) * 144 + (32 * s + 8 * g) * 2), bb = *(const LAS bf16x8_t*)(lds + GL_KS + (16 * tc + n) * 144 + (32 * s + 8 * g) * 2);
                            acc = __builtin_amdgcn_mfma_f32_16x16x32_bf16(a, bb, acc, 0, 0, 0); } }
#pragma unroll
                    for (int r = 0; r < 4; ++r) { const int t = 16 * tr + 4 * g + r, s = 16 * tc + n; lds_st16(lds + GL_PS + t * 144 + s * 2, (tc <= tr && s <= t) ? acc[r] : 0.f); } }
                __syncthreads();
            }
            bf16x8_t vf[2];
#pragma unroll
            for (int s = 0; s < 2; ++s) vf[s] = cat8(lds_tr(lds + GL_VS + (32 * s + 8 * g + q_) * 288 + (16 * w + 4 * p_) * 2), lds_tr(lds + GL_VS + (32 * s + 8 * g + 4 + q_) * 288 + (16 * w + 4 * p_) * 2));
            f32x4_t O[4];
            if (OUT) {
                bf16x8_t sb[2];
#pragma unroll
                for (int s = 0; s < 2; ++s) { u32x4_t t4; t4.x = pk2(S[2 * s][0], S[2 * s][1]); t4.y = pk2(S[2 * s][2], S[2 * s][3]); t4.z = pk2(S[2 * s + 1][0], S[2 * s + 1][1]); t4.w = pk2(S[2 * s + 1][2], S[2 * s + 1][3]); sb[s] = __builtin_bit_cast(bf16x8_t, t4); }
#pragma unroll
                for (int tl = 0; tl < 4; ++tl) { f32x4_t o = {0.f, 0.f, 0.f, 0.f};
#pragma unroll
                    for (int s = 0; s < 2; ++s) { const LAS unsigned char* qp = lds + GL_QS + (16 * tl + n) * 144 + (32 * s + 4 * g) * 2;
                        const bf16x8_t aq = cat8(*(const LAS s16x4_t*)qp, *(const LAS s16x4_t*)(qp + 32)); o = __builtin_amdgcn_mfma_f32_16x16x32_bf16(aq, sb[s], o, 0, 0, 0); }
#pragma unroll
                    for (int s = 0; s < 2; ++s) { const bf16x8_t ap = *(const LAS bf16x8_t*)(lds + GL_PS + (16 * tl + n) * 144 + (32 * s + 8 * g) * 2); o = __builtin_amdgcn_mfma_f32_16x16x32_bf16(ap, vf[s], o, 0, 0, 0); }
                    O[tl] = o; }
            }
#pragma unroll
            for (int i = 0; i < 4; ++i) {
#pragma unroll
                for (int r = 0; r < 4; ++r) S[i][r] *= DEC[16 * i + 4 * g + r];
#pragma unroll
                for (int s = 0; s < 2; ++s) { const bf16x8_t ak = cat8(lds_tr(lds + GL_KH + (32 * s + 8 * g + q_) * 160 + (16 * i + 4 * p_) * 2), lds_tr(lds + GL_KH + (32 * s + 8 * g + 4 + q_) * 160 + (16 * i + 4 * p_) * 2));
                    S[i] = __builtin_amdgcn_mfma_f32_16x16x32_bf16(ak, vf[s], S[i], 0, 0, 0); } }
            if (OUT) {
#pragma unroll
                for (int tl = 0; tl < 4; ++tl)
#pragma unroll
                    for (int r = 0; r < 4; ++r) { float v = row_sum16_f(O[tl][r] * O[tl][r]);
                        if (n == 0) SSQ[w * 64 + 16 * tl + 4 * g + r] = v; }
                __syncthreads();
                if (tid < 64) { float tv = 0.f;
#pragma unroll
                    for (int ww = 0; ww < 8; ++ww) tv += SSQ[ww * 64 + tid];
                    RSTD[tid] = rsqrtf(tv * (1.f / GLA_DV) + RMS_EPS); }
                __syncthreads();
                const int col = h * 128 + 16 * w + n; const float gain = P.gla_norm_g[col];
#pragma unroll
                for (int tl = 0; tl < 4; ++tl)
#pragma unroll
                    for (int r = 0; r < 4; ++r) { const int t = 16 * tl + 4 * g + r; const float rg = bf2f(rgraw[4 * tl + r]);
                        OMIX[(r0 + t) * DM + col] = (bf16_t)f2bf(O[tl][r] * RSTD[t] * gain * silu_f(rg)); }
            }
        }
#undef GLA_PREFETCH
        if (!OUT) {
#pragma unroll
            for (int i = 0; i < 4; ++i)
#pragma unroll
                for (int r = 0; r < 4; ++r) GU[(size_t)item * 8192 + (16 * i + 4 * g + r) * 128 + 16 * w + n] = S[i][r];
            if (part == 0) GD[(size_t)item * 64 + ch] = gdec;
        }
    }
}

constexpr int SW_K = 0, SW_V = 2 * 256 * 144, SW_SSQ = SW_V + 2 * 256 * 128, SW_RL = SW_SSQ + 512, SW_END = SW_RL + 8 * 32 * 4;
static_assert(SW_END <= MISC_OFF, "SWA LDS map");
__device__ __forceinline__ void phase_swa(const Params& P, LAS unsigned char* lds, int vb, int G) {
    const int tid = opaque_tid(), lane = tid & 63, w = tid >> 6, a = lane & 31, hi = lane >> 5;
    const bf16_t* PROJ = (const bf16_t*)(P.ws + WS_PROJ); bf16_t* OMIX = (bf16_t*)(P.ws + WS_OMIX);
    LAS float* SSQ = (LAS float*)(lds + SW_SSQ);
    const int kvh = w >> 2;
    const float slope2 = exp2f(-(float)(w + 1)) * 1.4426950408889634f, sink2 = P.swa_sinks[w] * 1.4426950408889634f;
    for (int item = vb; item < NT / 128; item += G) {
        const size_t row0 = (size_t)item * 128; const int nb = item & 63;
        __syncthreads();
#pragma unroll 4
        for (int j = 0; j < 16; ++j) { const int idx = tid + 512 * j, isv = idx >> 12, kv = (idx >> 11) & 1, kj = (idx >> 3) & 255, cc = idx & 7;
            u32x4_t v = {0u, 0u, 0u, 0u};
            if (nb > 0 || kj >= 128) v = *(const u32x4_t*)(PROJ + (row0 - 128 + kj) * PROJ_W + (isv ? C_VS : C_KS) + kv * 64 + cc * 8);
            if (isv) *(LAS u32x4_t*)(lds + SW_V + (kv * 256 + kj) * 128 + ((cc ^ (((kj >> 1) & 1) << 2)) * 16)) = v;
            else *(LAS u32x4_t*)(lds + SW_K + (kv * 256 + kj) * 144 + cc * 16) = v; }
        if (tid < 128) SSQ[tid] = 0.f;
        __syncthreads();
#pragma unroll 1
        for (int p = 0; p < 4; ++p) {
            bf16x8_t qf[4];
            { const bf16_t* qp = PROJ + (row0 + 32 * p + a) * PROJ_W + C_QS + w * 64 + 8 * hi;
#pragma unroll
              for (int s = 0; s < 4; ++s) qf[s] = *(const bf16x8_t*)(qp + 16 * s); }
            const float lt = slope2 * (float)(4 * hi - a); const int al = a - 4 * hi;
#define SWA_QK(jt, accv) do { const float sj_ = lt - slope2 * (float)(128 - 32 * (jt)); \
                _Pragma("unroll") for (int r_ = 0; r_ < 16; ++r_) accv[r_] = fmaf(slope2, (float)((r_ & 3) + 8 * (r_ >> 2)), sj_); \
                const LAS unsigned char* kp_ = lds + SW_K + (kvh * 256 + 32 * (p + (jt)) + a) * 144 + 16 * hi; \
                _Pragma("unroll") for (int s_ = 0; s_ < 4; ++s_) accv = __builtin_amdgcn_mfma_f32_32x32x16_bf16(*(const LAS bf16x8_t*)(kp_ + 32 * s_), qf[s_], accv, 0, 0, 0); \
                if ((jt) == 0) { _Pragma("unroll") for (int r_ = 0; r_ < 16; ++r_) accv[r_] = ((r_ & 3) + 8 * (r_ >> 2)) > al ? accv[r_] : -INFINITY; } \
                if ((jt) == 4) { _Pragma("unroll") for (int r_ = 0; r_ < 16; ++r_) accv[r_] = ((r_ & 3) + 8 * (r_ >> 2)) <= al ? accv[r_] : -INFINITY; } } while (0)
            float mx = sink2;
#pragma unroll
            for (int jt = 0; jt < 5; ++jt) { if (nb > 0 || p + jt >= 4) { f32x16_t acc; SWA_QK(jt, acc);
#pragma unroll
                for (int r = 0; r < 16; ++r) mx = fmaxf(mx, acc[r]); } }
            mx = fmaxf(mx, __shfl_xor(mx, 32));
            float l = 0.f; f32x16_t o0 = {}, o1 = {};
            const int rq = ((lane & 15) >> 2), cb = ((lane >> 4) & 1) * 32 + (lane & 3) * 8, swz = ((rq >> 1) & 1) << 6;
#pragma unroll
            for (int jt = 0; jt < 5; ++jt) { if (nb > 0 || p + jt >= 4) { f32x16_t acc; SWA_QK(jt, acc);
#pragma unroll
                for (int r = 0; r < 16; ++r) { const float e = __builtin_amdgcn_exp2f(acc[r] - mx); acc[r] = e; l += e; }
#pragma unroll
                for (int s = 0; s < 2; ++s) { u32x4_t pw;
                    pw.x = pk2(acc[8 * s + 0], acc[8 * s + 1]); pw.y = pk2(acc[8 * s + 2], acc[8 * s + 3]); pw.z = pk2(acc[8 * s + 4], acc[8 * s + 5]); pw.w = pk2(acc[8 * s + 6], acc[8 * s + 7]);
                    const bf16x8_t pa = __builtin_bit_cast(bf16x8_t, pw);
                    const LAS unsigned char* vA = lds + SW_V + (kvh * 256 + 32 * (p + jt) + 16 * s + 4 * hi + rq) * 128;
                    const bf16x8_t v0 = cat8(lds_tr(vA + (cb ^ swz)), lds_tr(vA + 8 * 128 + (cb ^ swz)));
                    const bf16x8_t v1 = cat8(lds_tr(vA + ((cb + 64) ^ swz)), lds_tr(vA + 8 * 128 + ((cb + 64) ^ swz)));
                    o0 = __builtin_amdgcn_mfma_f32_32x32x16_bf16(pa, v0, o0, 0, 0, 0);
                    o1 = __builtin_amdgcn_mfma_f32_32x32x16_bf16(pa, v1, o1, 0, 0, 0); } } }
#undef SWA_QK
            l += __shfl_xor(l, 32); l += __builtin_amdgcn_exp2f(sink2 - mx);
            LAS float* RL = (LAS float*)(lds + SW_RL) + w * 32;
            if (hi == 0) RL[a] = 1.f / l;
            asm volatile("s_waitcnt lgkmcnt(0)" ::: "memory");
#pragma unroll
            for (int r = 0; r < 16; ++r) { const float rl = RL[(r & 3) + 8 * (r >> 2) + 4 * hi]; o0[r] *= rl; o1[r] *= rl; }
#pragma unroll
            for (int r = 0; r < 16; ++r) { float v = o0[r] * o0[r] + o1[r] * o1[r];
                v = row_sum16_f(v); v += __shfl_xor(v, 16);
                if (a == 0) atomicAdd((float*)&SSQ[32 * p + (r & 3) + 8 * (r >> 2) + 4 * hi], v); }
            __syncthreads();
            const float g0 = P.swa_norm_g[w * 64 + a], g1 = P.swa_norm_g[w * 64 + 32 + a];
#pragma unroll
            for (int r = 0; r < 16; ++r) { const int q = (r & 3) + 8 * (r >> 2) + 4 * hi; const float rs = rsqrtf(SSQ[32 * p + q] * (1.f / 512.f) + RMS_EPS);
                bf16_t* op = OMIX + (row0 + 32 * p + q) * DM + 512 + w * 64 + a;
                op[0] = (bf16_t)f2bf(o0[r] * rs * g0); op[32] = (bf16_t)f2bf(o1[r] * rs * g1); }
        }
    }
}

struct EpiProj {
    static constexpr bool PERM = true, AFTER_DRAIN = false;
    bf16_t* proj; float* loga; const float* balpha;
    __device__ __forceinline__ void operator()(const pg8::f32x4 (&acc)[2][2][4][2], const pg8::Unit& u, int wr, int wc, int fr, int fq) const {
        const int row0 = u.pm * 256 + wr * 64 + fr;
        if (u.pn < 9) {
            const float sc = (u.pn == 0) ? 0.125f : (u.pn == 6 || u.pn == 7) ? 0.125f * 1.4426950408889634f : 1.f;
            const int col0 = u.pn * 256 + wc * 32 + 8 * fq;
#pragma unroll
            for (int ai = 0; ai < 2; ++ai)
#pragma unroll
                for (int m = 0; m < 4; ++m) { bf16_t* rowp = proj + (size_t)(row0 + ai * 128 + m * 16) * PROJ_W + col0;
#pragma unroll
                    for (int bj = 0; bj < 2; ++bj) { const pg8::f32x4 v0 = acc[ai][bj][m][0] * sc, v1 = acc[ai][bj][m][1] * sc;
                        u32x4_t w; w.x = pk2(v0[0], v0[1]); w.y = pk2(v0[2], v0[3]); w.z = pk2(v1[0], v1[1]); w.w = pk2(v1[2], v1[3]);
                        *(u32x4_t*)(rowp + bj * 128) = w; } }
        } else {
            const int col0 = wc * 32 + 8 * fq;
#pragma unroll
            for (int bj = 0; bj < 2; ++bj)
#pragma unroll
                for (int n = 0; n < 2; ++n) { const f32x4_t bv = *(const f32x4_t*)(balpha + col0 + bj * 128 + 4 * n);
#pragma unroll
                    for (int ai = 0; ai < 2; ++ai)
#pragma unroll
                        for (int m = 0; m < 4; ++m) { f32x4_t z = acc[ai][bj][m][n] + bv, o;
#pragma unroll
                            for (int j = 0; j < 4; ++j) o[j] = (fminf(z[j], 0.f) - __logf(1.f + __expf(-fabsf(z[j])))) * 0.0625f;
                            *(f32x4_t*)(loga + (size_t)(row0 + ai * 128 + m * 16) * 256 + col0 + bj * 128 + 4 * n) = o; } }
        }
    }
};
struct EpiOut {
    static constexpr bool PERM = true, AFTER_DRAIN = false;
    const float* x; const float* mod; bf16_t* x1; float* ssq;
    __device__ __forceinline__ void operator()(const pg8::f32x4 (&acc)[2][2][4][2], const pg8::Unit& u, int wr, int wc, int fr, int fq) const {
        const int row0 = u.pm * 256 + wr * 64 + fr, col0 = u.pn * 256 + wc * 32 + 8 * fq;
        const float* g1 = mod + (size_t)((u.pm * 256) / SEQ) * 6144 + 2048;
        f32x4_t ga[2], gb[2];
#pragma unroll
        for (int bj = 0; bj < 2; ++bj) { ga[bj] = *(const f32x4_t*)(g1 + col0 + bj * 128); gb[bj] = *(const f32x4_t*)(g1 + col0 + bj * 128 + 4); }
#pragma unroll
        for (int ai = 0; ai < 2; ++ai)
#pragma unroll
            for (int m = 0; m < 4; ++m) { const size_t ro = (size_t)(row0 + ai * 128 + m * 16) * DM + col0; float ss = 0.f;
#pragma unroll
                for (int bj = 0; bj < 2; ++bj) { const f32x4_t xa = *(const f32x4_t*)(x + ro + bj * 128), xb = *(const f32x4_t*)(x + ro + bj * 128 + 4);
                    const f32x4_t v0 = xa + acc[ai][bj][m][0] * ga[bj], v1 = xb + acc[ai][bj][m][1] * gb[bj];
                    ss += v0[0] * v0[0] + v0[1] * v0[1] + v0[2] * v0[2] + v0[3] * v0[3] + v1[0] * v1[0] + v1[1] * v1[1] + v1[2] * v1[2] + v1[3] * v1[3];
                    u32x4_t w; w.x = pk2(v0[0], v0[1]); w.y = pk2(v0[2], v0[3]); w.z = pk2(v1[0], v1[1]); w.w = pk2(v1[2], v1[3]);
                    *(u32x4_t*)(x1 + ro + bj * 128) = w; }
                ss += __shfl_xor(ss, 16); ss += __shfl_xor(ss, 32);
                if (fq == 0) atomicAdd(ssq + (row0 + ai * 128 + m * 16), ss); }
    }
};
struct EpiKey {
    static constexpr bool PERM = false, AFTER_DRAIN = false;
    unsigned* skey; const float* ssq; const float* cb;
    __device__ __forceinline__ void operator()(const pg8::f32x4 (&acc)[2][2][4][2], const pg8::Unit& u, int wr, int wc, int fr, int fq) const {
        const int row0 = u.pm * 256 + wr * 64 + fr, col0 = u.pn * 256 + wc * 32 + 4 * fq;
        const float* cbb = cb + (size_t)((u.pm * 256) / SEQ) * 2048;
        const bool lo = fr < 8;
        float rs[2][4];
#pragma unroll
        for (int ai = 0; ai < 2; ++ai)
#pragma unroll
            for (int m = 0; m < 4; ++m) rs[ai][m] = rsqrtf(ssq[row0 + ai * 128 + m * 16] * (1.f / DM) + RMS_EPS);
#pragma unroll
        for (int bj = 0; bj < 2; ++bj) { const int c = col0 + bj * 128; const unsigned ib = 127u - (unsigned)(c & 127);
            const f32x4_t cv0 = *(const f32x4_t*)(cbb + c), cv1 = *(const f32x4_t*)(cbb + c + 16);
#pragma unroll
            for (int ai = 0; ai < 2; ++ai)
#pragma unroll
                for (int m = 0; m < 4; ++m) { const f32x4_t v0 = acc[ai][bj][m][0] * rs[ai][m] + cv0, v1 = acc[ai][bj][m][1] * rs[ai][m] + cv1; u32x4_t X, Y, Z;
                    X.x = (f2key(v0[0]) & ~127u) | ib; X.y = (f2key(v0[1]) & ~127u) | (ib - 1u); X.z = (f2key(v0[2]) & ~127u) | (ib - 2u); X.w = (f2key(v0[3]) & ~127u) | (ib - 3u);
                    Y.x = (f2key(v1[0]) & ~127u) | (ib - 16u); Y.y = (f2key(v1[1]) & ~127u) | (ib - 17u); Y.z = (f2key(v1[2]) & ~127u) | (ib - 18u); Y.w = (f2key(v1[3]) & ~127u) | (ib - 19u);
#pragma unroll
                    for (int q = 0; q < 4; ++q) Z[q] = (unsigned)__builtin_amdgcn_mov_dpp((int)Y[q], 0x128, 0xf, 0xf, false);
                    unsigned* base = skey + (size_t)(u.pm * 256 + wr * 64 + ai * 128 + m * 16 + (fr & 7)) * 2048 + c;
                    u32x4_t dA, dB;
#pragma unroll
                    for (int q = 0; q < 4; ++q) { dA[q] = lo ? X[q] : Z[q]; dB[q] = lo ? Z[q] : X[q]; }
                    *(u32x4_t*)(base + (lo ? 0 : 16)) = dA;
                    *(u32x4_t*)(base + (size_t)8 * 2048 + (lo ? 16 : 0)) = dB; }
        }
    }
};

__device__ __forceinline__ void transpose_write(LAS float* scr, bf16_t* WT, int row_dst0, int K, int k0, int lane) {
    const int c = lane & 7;
#pragma unroll
    for (int j = 0; j < 4; ++j) { const int n = (lane >> 3) + 8 * j; const LAS float* s = scr + (8 * c) * 33 + n;
        u32x4_t o; o.x = pk2(s[0 * 33], s[1 * 33]); o.y = pk2(s[2 * 33], s[3 * 33]); o.z = pk2(s[4 * 33], s[5 * 33]); o.w = pk2(s[6 * 33], s[7 * 33]);
        *(u32x4_t*)(WT + (size_t)(row_dst0 + n) * K + k0 + 8 * c) = o; }
}
__device__ __forceinline__ void phase_prep(const Params& P, LAS unsigned char* lds, int vb, int G) {
    const int tid0 = opaque_tid();
    unsigned char* ws = P.ws;
    bf16_t* WTIN = (bf16_t*)(ws + WS_WTIN); bf16_t* WTOUT = (bf16_t*)(ws + WS_WTOUT); float* WPF = (float*)(ws + WS_WPF);
    float* MOD = (float*)(ws + WS_MOD);
    constexpr int I_PK = 256, I_MOD = 96, I_TR = 224, NITEMS = I_PK + I_MOD + I_TR;
    for (int stage = 0; stage < 2; ++stage) {
    if ((stage ^ (vb & 1)) == 0) {
    for (int it = vb; it < NITEMS; it += G) {
        int tid = tid0; asm volatile("" : "+v"(tid));
        const int lane = tid & 63, wave = tid >> 6;
        __syncthreads();
        if (it < I_PK) {
            const int kb = it >> 4, g = it & 15, k0 = kb * 64;
            LAS float* A = (LAS float*)lds;
            LAS float* Kt = (LAS float*)(lds + 32768);
            const float* keys = (g & 1) ? P.peer_keys_2 : P.peer_keys_1;
#pragma unroll 4
            for (int i = 0; i < 16; ++i) { const int idx = i * 512 + tid, kk = idx >> 7, d = idx & 127; A[idx] = P.w_peer_q[(size_t)(k0 + kk) * 2048 + g * 128 + d]; }
#pragma unroll 4
            for (int i = 0; i < 32; ++i) { const int idx = i * 512 + tid, n = idx >> 7, d = idx & 127; Kt[d * 129 + n] = keys[idx]; }
            __syncthreads();
            const int n = tid & 127, ks = tid >> 7;
            float acc[16];
#pragma unroll
            for (int i = 0; i < 16; ++i) acc[i] = 0.f;
            for (int d = 0; d < 128; d += 4) {
                const float k0v = Kt[(d + 0) * 129 + n], k1v = Kt[(d + 1) * 129 + n], k2v = Kt[(d + 2) * 129 + n], k3v = Kt[(d + 3) * 129 + n];
#pragma unroll
                for (int i = 0; i < 16; ++i) { const f32x4_t a = *(const LAS f32x4_t*)(A + (ks * 16 + i) * 128 + d); acc[i] += a[0] * k0v + a[1] * k1v + a[2] * k2v + a[3] * k3v; }
            }
            float* dst = WPF + (size_t)(g * 128 + n) * 1024 + k0 + ks * 16;
#pragma unroll
            for (int i = 0; i < 4; ++i) { const f32x4_t o = {acc[4 * i], acc[4 * i + 1], acc[4 * i + 2], acc[4 * i + 3]}; *(f32x4_t*)(dst + 4 * i) = o; }
        } else if (it < I_PK + I_MOD) {
            const int col = (it - I_PK) * 64 + lane;
            LAS float* cact = (LAS float*)lds;
            LAS float* red = (LAS float*)(lds + 16384);
#pragma unroll
            for (int i = 0; i < 8; ++i) { const int idx = i * 512 + tid; cact[idx] = silu_f(P.c[idx]); }
            __syncthreads();
            float a0 = 0.f, a1 = 0.f, a2 = 0.f, a3 = 0.f;
#pragma unroll 8
            for (int kk = 0; kk < 128; ++kk) { const int k = wave * 128 + kk; const float w = P.w_ada[(size_t)k * 6144 + col];
                a0 += cact[k] * w; a1 += cact[1024 + k] * w; a2 += cact[2048 + k] * w; a3 += cact[3072 + k] * w; }
            red[(wave * 4 + 0) * 64 + lane] = a0; red[(wave * 4 + 1) * 64 + lane] = a1; red[(wave * 4 + 2) * 64 + lane] = a2; red[(wave * 4 + 3) * 64 + lane] = a3;
            __syncthreads();
            if (tid < 256) { const int b = tid >> 6; float s = P.b_ada[col];
#pragma unroll
                for (int w = 0; w < 8; ++w) s += red[(w * 4 + b) * 64 + lane];
                MOD[b * 6144 + col] = s; }
        } else {
            const int wi = (it - I_PK - I_MOD) * 8 + wave;
            LAS float* scr = (LAS float*)(lds + wave * 8448);
            if (wi < 1152) { const int kb = wi / 72, nb = wi % 72, k0 = kb * 64, n0 = nb * 32, ns = n0 < 1024 ? n0 : n0 + 16;
#pragma unroll 8
                for (int i = 0; i < 32; ++i) { const int kk = 2 * i + (lane >> 5); scr[kk * 33 + (lane & 31)] = P.w_in[(size_t)(k0 + kk) * IN_W + ns + (lane & 31)]; }
                asm volatile("s_waitcnt lgkmcnt(0)" ::: "memory");
                transpose_write(scr, WTIN, n0, 1024, k0, lane);
            } else if (wi < 1664) { const int w2 = wi - 1152, kb = w2 / 32, nb = w2 % 32, k0 = kb * 64, n0 = nb * 32;
#pragma unroll 8
                for (int i = 0; i < 32; ++i) { const int kk = 2 * i + (lane >> 5); scr[kk * 33 + (lane & 31)] = P.w_out[(size_t)(k0 + kk) * 1024 + n0 + (lane & 31)]; }
                asm volatile("s_waitcnt lgkmcnt(0)" ::: "memory");
                transpose_write(scr, WTOUT, n0, 1024, k0, lane);
            } else { const int w2 = wi - 1664, kb = w2 / 8, nb = w2 % 8, k0 = kb * 64, n0 = nb * 32;
                for (int i = 0; i < 32; ++i) { const int kk = 2 * i + (lane >> 5); const float* wr_ = P.w_in + (size_t)(k0 + kk) * IN_W + 1024; float s = 0.f;
#pragma unroll
                    for (int r = 0; r < 16; ++r) s += wr_[r] * P.w_gla_alpha[r * 256 + n0 + (lane & 31)];
                    scr[kk * 33 + (lane & 31)] = s; }
                asm volatile("s_waitcnt lgkmcnt(0)" ::: "memory");
                transpose_write(scr, WTIN, 2304 + n0, 1024, k0, lane);
            }
            asm volatile("s_waitcnt lgkmcnt(0)" ::: "memory");
        }
    }
    } else {
    {
        int tid = tid0; asm volatile("" : "+v"(tid)); const int lane = tid & 63, wave = tid >> 6;
        unsigned* UQ = (unsigned*)(ws + WS_UBF); unsigned* VQ = (unsigned*)(ws + WS_VBF); float* USC = (float*)(ws + WS_USC); float* VSC = (float*)(ws + WS_VSC);
        for (int r0 = (vb * NWAVES + wave) * 4; r0 < 2 * PEER_NE; r0 += G * NWAVES * 4) {
            f32x4_t v[4][4];
#pragma unroll
            for (int k = 0; k < 4; ++k) { const int r = r0 + k; const bool second = r >= PEER_NE; const float* src = (second ? P.peer_v : P.peer_u) + (size_t)(second ? r - PEER_NE : r) * DM;
#pragma unroll
                for (int j = 0; j < 4; ++j) v[k][j] = *(const f32x4_t*)(src + 4 * lane + 256 * j); }
#pragma unroll
            for (int k = 0; k < 4; ++k) { const int r = r0 + k; const bool second = r >= PEER_NE; const int e = second ? r - PEER_NE : r; float mx = 0.f;
#pragma unroll
                for (int j = 0; j < 4; ++j) mx = fmaxf(mx, fmaxf(fmaxf(fabsf(v[k][j][0]), fabsf(v[k][j][1])), fmaxf(fabsf(v[k][j][2]), fabsf(v[k][j][3]))));
                mx = row_max16_f(mx); mx = fmaxf(mx, __shfl_xor(mx, 16)); mx = fmaxf(mx, __shfl_xor(mx, 32));
                const float sc = fmaxf(mx, 1e-30f) * (1.f / 127.f), inv = 1.f / sc;
                unsigned* dst = (second ? VQ : UQ) + (size_t)e * 256;
#pragma unroll
                for (int j = 0; j < 4; ++j) { unsigned w = 0;
#pragma unroll
                    for (int q = 0; q < 4; ++q) { const int bq = (int)rintf(v[k][j][q] * inv); w |= ((unsigned)bq & 255u) << (8 * q); }
                    dst[lane + 64 * j] = w; }
                if (lane == 0) (second ? VSC : USC)[e] = sc; }
        }
    }
    }
    }
    { float* SSQ2 = (float*)(ws + WS_SSQ2); for (int i = vb * NTHREADS + tid0; i < NT; i += G * NTHREADS) SSQ2[i] = 0.f; }
}

__device__ __forceinline__ void phase_normmod(const float* src, const bf16_t* add, const float* gain, const float* mod, int shift_off, int scale_off, bf16_t* dst, int vb, int G) {
    const int tid = opaque_tid(), lane = tid & 63, wave = tid >> 6;
    for (int row = vb * NWAVES + wave; row < NT; row += G * NWAVES) {
        const float* xr = src + (size_t)row * DM; const float* mb = mod + (size_t)(row / SEQ) * 6144;
        f32x4_t v[4]; float s = 0.f;
#pragma unroll
        for (int j = 0; j < 4; ++j) { v[j] = *(const f32x4_t*)(xr + 4 * lane + 256 * j);
            if (add) { const u32x2_t yv = *(const u32x2_t*)(add + (size_t)row * DM + 4 * lane + 256 * j); v[j][0] += bflo(yv.x); v[j][1] += bfhi(yv.x); v[j][2] += bflo(yv.y); v[j][3] += bfhi(yv.y); }
            s += v[j][0] * v[j][0] + v[j][1] * v[j][1] + v[j][2] * v[j][2] + v[j][3] * v[j][3]; }
        const float rstd = rsqrtf(wave_sum(s) * (1.f / DM) + RMS_EPS);
#pragma unroll
        for (int j = 0; j < 4; ++j) { const int c = 4 * lane + 256 * j;
            const f32x4_t g = *(const f32x4_t*)(gain + c), sh = *(const f32x4_t*)(mb + shift_off + c), sc = *(const f32x4_t*)(mb + scale_off + c);
            const f32x4_t h = (v[j] * rstd) * g * (sc + 1.f) + sh;
            u32x2_t o; o.x = pk2(h[0], h[1]); o.y = pk2(h[2], h[3]);
            *(u32x2_t*)(dst + (size_t)row * DM + c) = o; }
    }
}

__device__ __forceinline__ void phase_wpk_batch(const Params& P, int vb, int G) {
    const int tid = opaque_tid(), lane = tid & 63, wave = tid >> 6;
    const float* WPF = (const float*)(P.ws + WS_WPF); const float* MOD = (const float*)(P.ws + WS_MOD); bf16_t* WB = (bf16_t*)(P.ws + WS_WTPKB); float* CB = (float*)(P.ws + WS_CB);
    for (int it = vb * NWAVES + wave; it < NB * 2048; it += G * NWAVES) {
        const int b = it >> 11, n = it & 2047; const float* mb = MOD + (size_t)b * 6144; float dot = 0.f;
#pragma unroll
        for (int j = 0; j < 4; ++j) { const int c = 4 * lane + 256 * j;
            const f32x4_t w = *(const f32x4_t*)(WPF + (size_t)n * 1024 + c), gn = *(const f32x4_t*)(P.norm2_g + c), sc = *(const f32x4_t*)(mb + 4096 + c), sh = *(const f32x4_t*)(mb + 3072 + c);
            const f32x4_t o = w * gn * (sc + 1.f); dot += w[0] * sh[0] + w[1] * sh[1] + w[2] * sh[2] + w[3] * sh[3];
            u32x2_t pk; pk.x = pk2(o[0], o[1]); pk.y = pk2(o[2], o[3]); *(u32x2_t*)(WB + ((size_t)b * 2048 + n) * 1024 + c) = pk; }
        dot = wave_sum(dot);
        if (lane == 0) CB[b * 2048 + n] = dot;
    }
}


__device__ __forceinline__ void route_quad(const unsigned* SKEY, int t0, LAS unsigned* stage, LAS unsigned char* idxb, LAS unsigned* raw, int tokbase, int lane) {
    unsigned L[16];
#pragma unroll
    for (int j = 0; j < 16; ++j) L[j] = 0u;
    for (int p = 0; p < 4; ++p) {
        asm volatile("s_waitcnt lgkmcnt(0)" ::: "memory");
#pragma unroll
        for (int i = 0; i < 8; ++i) { const int seg = i * 8 + (lane >> 3), ch = lane & 7;
            const u32x4_t v = *(const u32x4_t*)(SKEY + (size_t)(t0 + (seg >> 4)) * 2048 + (seg & 15) * 128 + p * 32 + ch * 4);
            *(LAS u32x4_t*)(stage + seg * 36 + ch * 4) = v; }
        asm volatile("s_waitcnt lgkmcnt(0)" ::: "memory");
#pragma unroll
        for (int hf_ = 0; hf_ < 2; ++hf_) { unsigned N[16];
#pragma unroll
            for (int cch = 0; cch < 4; ++cch) { const u32x4_t v = *(const LAS u32x4_t*)(stage + lane * 36 + (hf_ * 4 + cch) * 4); N[4 * cch] = v.x; N[4 * cch + 1] = v.y; N[4 * cch + 2] = v.z; N[4 * cch + 3] = v.w; }
            sort16_desc(N); merge_top16(L, N); }
    }
#pragma unroll
    for (int j = 0; j < 4; ++j) { unsigned w = 0;
#pragma unroll
        for (int q = 0; q < 4; ++q) w |= (127u - (L[4 * j + q] & 127u)) << (8 * q);
        *(LAS unsigned*)(idxb + lane * 16 + 4 * j) = w; }
    float v1[16], v2[16];
    { const bool odd = lane & 1;
#pragma unroll
      for (int j = 0; j < 16; ++j) { const float mine = key2f(L[j] & ~127u); const float oth = dpp_swap1_f(mine); v1[j] = odd ? oth : mine; v2[j] = odd ? mine : oth; } }
#define CKEY(i, j) ((f2key(v1[i] + v2[j]) & ~255u) | (255u - (unsigned)((i) * 16 + (j))))
    unsigned C[16];
#pragma unroll
    for (int j = 0; j < 16; ++j) C[j] = CKEY(0, j);
    { unsigned N[16] = {CKEY(1, 0), CKEY(1, 1), CKEY(1, 2), CKEY(1, 3), CKEY(1, 4), CKEY(1, 5), CKEY(1, 6), CKEY(1, 7), CKEY(2, 0), CKEY(2, 1), CKEY(2, 2), CKEY(2, 3), CKEY(2, 4), CKEY(4, 0), CKEY(4, 1), CKEY(4, 2)};
      sort16_desc(N); merge_top16(C, N); }
    { unsigned N[16] = {CKEY(3, 0), CKEY(3, 1), CKEY(3, 2), CKEY(3, 3), CKEY(5, 0), CKEY(5, 1), CKEY(6, 0), CKEY(6, 1), CKEY(7, 0), CKEY(7, 1), CKEY(8, 0), CKEY(9, 0), CKEY(10, 0), CKEY(11, 0), CKEY(12, 0), CKEY(13, 0)};
      sort16_desc(N); merge_top16(C, N); }
    insert16(C, CKEY(14, 0)); insert16(C, CKEY(15, 0));
#undef CKEY
    asm volatile("s_waitcnt lgkmcnt(0)" ::: "memory");
    const float mx = key2f(C[0] & ~255u); float e[16], se = 0.f;
#pragma unroll
    for (int j = 0; j < 16; ++j) { e[j] = __expf(key2f(C[j] & ~255u) - mx); se += e[j]; }
    const float rs = 32768.f / se;
    if (!(lane & 1)) { const int tok = lane >> 4, head = (lane & 15) >> 1;
#pragma unroll
        for (int j = 0; j < 16; ++j) { const unsigned code = 255u - (C[j] & 255u); const unsigned e1 = idxb[lane * 16 + (code >> 4)], e2 = idxb[(lane + 1) * 16 + (code & 15u)];
            unsigned g15 = (unsigned)(e[j] * rs); g15 = g15 > 32767u ? 32767u : g15;
            raw[tok * 128 + head * 16 + j] = (e1 * 128u + e2) | ((unsigned)(tokbase + tok) << 14) | (g15 << 17); } }
    asm volatile("s_waitcnt lgkmcnt(0)" ::: "memory");
}

__device__ __forceinline__ float gelu_erf(float v) {
    const float av = fabsf(v), t = __builtin_amdgcn_rcpf(av * 0.2316418882f + 1.0f);
    float q = t * 0.5307027145f + (-0.7265760135f); q = q * t + 0.7107068705f; q = q * t + (-0.142248368f); q = q * t + 0.127414796f; q = q * t;
    const float m = v * (q * __builtin_amdgcn_exp2f((v * v) * (-0.72134752044f)));
    return v < 0.f ? m : v - m;
}
__device__ __forceinline__ int dot16_i8(const u32x4_t b, const unsigned h0, const unsigned h1, const unsigned h2, const unsigned h3, int s) {
    s = __builtin_amdgcn_sdot4((int)b.x, (int)h0, s, false); s = __builtin_amdgcn_sdot4((int)b.y, (int)h1, s, false);
    s = __builtin_amdgcn_sdot4((int)b.z, (int)h2, s, false); return __builtin_amdgcn_sdot4((int)b.w, (int)h3, s, false);
}
constexpr int P4_SLOT = 10304  , P4_SLOTS = 0, P4_RA = 8 * P4_SLOT, P4_RAW = 9216, P4_IDX = 13312, P4_CNT = 14336, P4_RSZ = 15360, P4_TBL = P4_RA + 4 * P4_RSZ, P4_FLG = P4_TBL + 16384;
static_assert(P4_FLG + 64 <= MISC_OFF, "peer (specialised) LDS map");

template <bool WRITE, int MASK> __device__ __forceinline__ void gather_sweep(const Params& P, LAS unsigned* MK, LAS float* MS, LAS float* MV, const unsigned (&hq)[16], float sh, size_t row, int li,
                                                                   const LAS float* GT2L, const LAS float* FGL) {
    const unsigned* UQ = (const unsigned*)(P.ws + WS_UBF); const unsigned* VQ = (const unsigned*)(P.ws + WS_VBF); const bf16_t* X1 = (const bf16_t*)(P.ws + WS_X1);
    const unsigned lo = (unsigned)li * 4u; float wmx = 0.f;
#define P3_LOAD(NB, buf, eidv, s, TAB) do { _Pragma("unroll") for (int u_ = 0; u_ < NB; ++u_) { eidv[u_] = MK[(s) + u_]; const unsigned* rp_ = TAB + (size_t)eidv[u_] * 256 + lo; \
        _Pragma("unroll") for (int j_ = 0; j_ < 4; ++j_) buf[u_][j_] = *(const u32x4_t*)(rp_ + 64 * j_); } } while (0)
    u32x4_t vA[2][4], vB[2][4]; unsigned fA[2], fB[2];
    if (MASK & 2) {
        u32x4_t bA[4][4], bB[4][4]; unsigned eA[4], eB[4];
#define P3_DPPI(v_, ctl_) __builtin_amdgcn_mov_dpp((v_), (ctl_), 0xf, 0xf, false)
#define P3_UCOMP(buf, eidv, s) do { int dd_[4]; \
            _Pragma("unroll") for (int u_ = 0; u_ < 4; ++u_) { int d_ = 0; \
                _Pragma("unroll") for (int j_ = 0; j_ < 4; ++j_) d_ = dot16_i8(buf[u_][j_], hq[4 * j_], hq[4 * j_ + 1], hq[4 * j_ + 2], hq[4 * j_ + 3], d_); \
                dd_[u_] = d_; } \
              \
              \
            const int s0_ = h8 ? dd_[0] : dd_[2], s1_ = h8 ? dd_[1] : dd_[3]; const int r0_ = P3_DPPI(s0_, 0x128), r1_ = P3_DPPI(s1_, 0x128);     \
            const int k0_ = (h8 ? dd_[2] : dd_[0]) + r0_; \
            const int k1_ = (h8 ? dd_[3] : dd_[1]) + r1_; \
            const int sn_ = h4 ? k0_ : k1_; const int pa_ = P3_DPPI(sn_, 0x124), pb_ = P3_DPPI(sn_, 0x12C); const int pr_ = h4 ? pa_ : pb_;     \
            int m_ = (h4 ? k1_ : k0_) + pr_; \
            m_ += P3_DPPI(m_, 0x4E); m_ += P3_DPPI(m_, 0xB1);     \
            const int si_ = (s) + rsel; \
            const float a_ = MS[si_] * sh * (float)m_; const float w_ = MV[si_] * gelu_erf(a_); \
            if ((li & 3) == 0) { MV[si_] = w_; wmx = fmaxf(wmx, fabsf(w_)); } } while (0)
        const bool h8 = li & 8, h4 = li & 4; const int rsel = (h8 ? 2 : 0) + (h4 ? 1 : 0);
        P3_LOAD(4, bA, eA, 0, UQ);
#pragma unroll 1
        for (int s = 0; s < 128; s += 8) {
            P3_LOAD(4, bB, eB, s + 4, UQ);
            P3_UCOMP(bA, eA, s);
            if (s + 8 < 128) P3_LOAD(4, bA, eA, s + 8, UQ); else P3_LOAD(2, vA, fA, 0, VQ);
            P3_UCOMP(bB, eB, s + 4);
        }
#undef P3_UCOMP
    }
    asm volatile("s_waitcnt lgkmcnt(0)" ::: "memory");
    wmx = row_max16_f(wmx);
    u32x2_t xw[16];
#pragma unroll
    for (int j = 0; j < 4; ++j)
#pragma unroll
        for (int q = 0; q < 4; ++q) xw[4 * j + q] = *(const u32x2_t*)(X1 + row * DM + j * 256 + li * 16 + q * 4);
    const float wscale = fmaxf(wmx, 1e-30f) * (1.f / 127.f), winv = 1.f / wscale;
    int iacc[64];
#pragma unroll
    for (int q = 0; q < 64; ++q) iacc[q] = 0;
    if (MASK & 4) {
#define P3_VCOMP(NB, buf, eidv, s) do { const int wa_ = (int)rintf(MV[(s)] * winv) & 255, wb_ = (int)rintf(MV[(s) + 1] * winv) & 255; \
            const int w01_ = wa_ | (wb_ << 8), w23_ = w01_ << 16;     \
            _Pragma("unroll") for (int j_ = 0; j_ < 4; ++j_) _Pragma("unroll") for (int q_ = 0; q_ < 4; ++q_) { const unsigned ra_ = buf[0][j_][q_], rb_ = buf[1][j_][q_]; \
                const int t0_ = (int)__builtin_amdgcn_perm(rb_, ra_, 0x05010400u), t1_ = (int)__builtin_amdgcn_perm(rb_, ra_, 0x07030602u); \
                iacc[16 * j_ + 4 * q_] = __builtin_amdgcn_sdot4(t0_, w01_, iacc[16 * j_ + 4 * q_], false); iacc[16 * j_ + 4 * q_ + 1] = __builtin_amdgcn_sdot4(t0_, w23_, iacc[16 * j_ + 4 * q_ + 1], false); \
                iacc[16 * j_ + 4 * q_ + 2] = __builtin_amdgcn_sdot4(t1_, w01_, iacc[16 * j_ + 4 * q_ + 2], false); iacc[16 * j_ + 4 * q_ + 3] = __builtin_amdgcn_sdot4(t1_, w23_, iacc[16 * j_ + 4 * q_ + 3], false); } } while (0)
        if (!(MASK & 2)) P3_LOAD(2, vA, fA, 0, VQ);
#pragma unroll 1
        for (int s = 0; s < 128; s += 4) {
            P3_LOAD(2, vB, fB, s + 2, VQ);
            P3_VCOMP(2, vA, fA, s);
            if (s + 4 < 128) P3_LOAD(2, vA, fA, s + 4, VQ);
            P3_VCOMP(2, vB, fB, s + 2);
        }
#undef P3_VCOMP
    }
#undef P3_LOAD
    {
        float* xr = P.out + row * DM;
        float ssq = 0.f; float acc[64];
#pragma unroll
        for (int j = 0; j < 4; ++j)
#pragma unroll
            for (int q = 0; q < 4; ++q) { const int c = j * 256 + li * 16 + q * 4; const f32x4_t gv = *(const LAS f32x4_t*)(GT2L + c);
                const u32x2_t xw2 = xw[4 * j + q]; const float xv[4] = {bflo(xw2.x), bfhi(xw2.x), bflo(xw2.y), bfhi(xw2.y)};
#pragma unroll
                for (int rr = 0; rr < 4; ++rr) { const float v = xv[rr] + gv[rr] * ((float)iacc[16 * j + 4 * q + rr] * wscale); acc[16 * j + 4 * q + rr] = v; ssq += v * v; } }
        ssq = row_sum16_f(ssq);
        const float rstd = rsqrtf(ssq * (1.f / DM) + RMS_EPS);
#pragma unroll
        for (int j = 0; j < 4; ++j)
#pragma unroll
            for (int q = 0; q < 4; ++q) { const int c = j * 256 + li * 16 + q * 4; const f32x4_t fg = *(const LAS f32x4_t*)(FGL + c); f32x4_t o;
#pragma unroll
                for (int rr = 0; rr < 4; ++rr) o[rr] = acc[16 * j + 4 * q + rr] * rstd * fg[rr];
                if (WRITE) *(f32x4_t*)(xr + c) = o; else asm volatile("" :: "v"(o)); }
    }
}

template <bool WRITE, int MASK = 7> __device__ __forceinline__ void phase_peer3(const Params& P, LAS unsigned char* lds, int vb, int G) {
    const int tid = opaque_tid(), lane0 = tid & 63, wave = __builtin_amdgcn_readfirstlane(tid >> 6);
    const unsigned* SKEY = (const unsigned*)(P.ws + WS_SKEY); const bf16_t* X1 = (const bf16_t*)(P.ws + WS_X1);
    const float* USC = (const float*)(P.ws + WS_USC); const float* VSC = (const float*)(P.ws + WS_VSC);
    const float* MOD = (const float*)(P.ws + WS_MOD);
    const int blk = vb;
    LAS float* G2L = (LAS float*)(lds + P4_TBL); LAS float* B2L = G2L + 1024; LAS float* GT2L = G2L + 2048; LAS float* FGL = G2L + 3072;
    volatile LAS unsigned* FLG = (volatile LAS unsigned*)(lds + P4_FLG);
    { const float* mb = MOD + (size_t)((blk * 128) / SEQ) * 6144;
      for (int c = tid; c < 1024; c += NTHREADS) { G2L[c] = P.norm2_g[c] * (1.f + mb[4096 + c]); B2L[c] = mb[3072 + c]; GT2L[c] = mb[5120 + c]; FGL[c] = P.final_g[c]; }
      if (tid < 16) FLG[tid] = 0u; }
    __syncthreads();
    if (wave >= 4) {
        const int r = wave - 4;
        LAS unsigned char* ra = lds + P4_RA + r * P4_RSZ;
        LAS unsigned* RAW = (LAS unsigned*)(ra + P4_RAW); LAS unsigned char* IDX = ra + P4_IDX; LAS unsigned* CNT = (LAS unsigned*)(ra + P4_CNT);
#pragma unroll 1
        for (int sw = 0; sw < 8; ++sw) {
            int lane = lane0; asm volatile("" : "+v"(lane));
            const int g = lane >> 4, li = lane & 15;
            const int tw0 = blk * 128 + sw * 16 + r * 4;
            route_quad(SKEY, tw0, (LAS unsigned*)ra, IDX, RAW, 0, lane);
#pragma unroll
            for (int t = 0; t < 4; ++t) CNT[t * 64 + lane] = 0u;
            asm volatile("s_waitcnt lgkmcnt(0)" ::: "memory");
#pragma unroll
            for (int i = 0; i < 8; ++i) { const unsigned e = RAW[i * 64 + lane]; __hip_atomic_fetch_add(CNT + (i >> 1) * 64 + ((e & 0x3fffu) >> 8), 1u, __ATOMIC_RELAXED, __HIP_MEMORY_SCOPE_WORKGROUP); }
            asm volatile("s_waitcnt lgkmcnt(0)" ::: "memory");
#pragma unroll
            for (int t = 0; t < 4; ++t) { const unsigned c = CNT[t * 64 + lane]; const unsigned inc = wave_incl_scan_u32(c); CNT[t * 64 + lane] = inc - c + t * 128; }
            asm volatile("s_waitcnt lgkmcnt(0)" ::: "memory");
            if (sw >= 2) { unsigned spins = 0; while (FLG[4 + r] < (unsigned)(sw - 1) && ++spins < (1u << 22)) __builtin_amdgcn_s_sleep(8); }
            LAS unsigned char* sl = lds + P4_SLOTS + (r * 2 + (sw & 1)) * P4_SLOT;
            LAS unsigned* KEYS = (LAS unsigned*)sl; LAS float* SU = (LAS float*)(sl + 2048); LAS float* VALS = (LAS float*)(sl + 4096);
#pragma unroll
            for (int i = 0; i < 8; ++i) { const unsigned e = RAW[i * 64 + lane]; const unsigned pos = __hip_atomic_fetch_add(CNT + (i >> 1) * 64 + ((e & 0x3fffu) >> 8), 1u, __ATOMIC_RELAXED, __HIP_MEMORY_SCOPE_WORKGROUP);
                const unsigned eid = e & 0x3fffu; KEYS[pos] = eid; VALS[pos] = (float)(e >> 17) * (1.f / 32768.f) * VSC[eid]; SU[pos] = USC[eid]; }
            const size_t row = (size_t)(tw0 + g);
            unsigned hq[16]; float sh;
            {
              unsigned xw[32];
              const float rstd2 = rsqrtf(((const float*)(P.ws + WS_SSQ2))[row] * (1.f / DM) + RMS_EPS);
#pragma unroll
              for (int j = 0; j < 4; ++j) { const bf16_t* hp = X1 + row * DM + j * 256 + li * 16; const u32x4_t a = *(const u32x4_t*)hp, b = *(const u32x4_t*)(hp + 8);
#pragma unroll
                  for (int q = 0; q < 4; ++q) { xw[8 * j + q] = a[q]; xw[8 * j + 4 + q] = b[q]; } }
#define P3_H4(d_, h_) do { const int c_ = ((d_) >> 2) * 256 + li * 16 + ((d_) & 3) * 4; const f32x4_t gn_ = *(const LAS f32x4_t*)(G2L + c_), sf_ = *(const LAS f32x4_t*)(B2L + c_); \
                  const unsigned w0_ = xw[2 * (d_)], w1_ = xw[2 * (d_) + 1]; \
                  h_[0] = bflo(w0_) * rstd2 * gn_[0] + sf_[0]; h_[1] = bfhi(w0_) * rstd2 * gn_[1] + sf_[1]; h_[2] = bflo(w1_) * rstd2 * gn_[2] + sf_[2]; h_[3] = bfhi(w1_) * rstd2 * gn_[3] + sf_[3]; } while (0)
              float mx = 0.f;
#pragma unroll
              for (int d = 0; d < 16; ++d) { float h4[4]; P3_H4(d, h4); mx = fmaxf(mx, fmaxf(fmaxf(fabsf(h4[0]), fabsf(h4[1])), fmaxf(fabsf(h4[2]), fabsf(h4[3])))); }
              mx = row_max16_f(mx);
              sh = fmaxf(mx, 1e-30f) * (1.f / 127.f); const float inv = 1.f / sh;
#pragma unroll
              for (int d = 0; d < 16; ++d) { float h4[4]; P3_H4(d, h4); unsigned w = 0;
#pragma unroll
                  for (int q = 0; q < 4; ++q) w |= ((unsigned)(int)rintf(h4[q] * inv) & 255u) << (8 * q);
                  hq[d] = w; }
#undef P3_H4
            }
#pragma unroll
            for (int d4 = 0; d4 < 4; ++d4) { u32x4_t hv; hv.x = hq[4 * d4]; hv.y = hq[4 * d4 + 1]; hv.z = hq[4 * d4 + 2]; hv.w = hq[4 * d4 + 3]; *(LAS u32x4_t*)(sl + 6144 + lane * 64 + d4 * 16) = hv; }
            if (li == 0) ((LAS float*)(sl + 10240))[g] = sh;
            asm volatile("s_waitcnt vmcnt(0) lgkmcnt(0)" ::: "memory");
            if (lane == 0) FLG[r] = (unsigned)(sw + 1);
            asm volatile("s_waitcnt lgkmcnt(0)" ::: "memory");
        }
    } else {
        const int r = wave;
        __builtin_amdgcn_s_setprio(3);
#pragma unroll 1
        for (int sw = 0; sw < 8; ++sw) {
            int lane = lane0; asm volatile("" : "+v"(lane));
            const int g = lane >> 4, li = lane & 15;
            const int tw0 = blk * 128 + sw * 16 + r * 4;
            const size_t row = (size_t)(tw0 + g);
            { unsigned spins = 0; while (FLG[r] < (unsigned)(sw + 1) && ++spins < (1u << 22)) __builtin_amdgcn_s_sleep(8); }
            asm volatile("s_waitcnt lgkmcnt(0)" ::: "memory");
            LAS unsigned char* sl = lds + P4_SLOTS + (r * 2 + (sw & 1)) * P4_SLOT;
            unsigned hq[16]; const float sh = ((LAS float*)(sl + 10240))[g];
#pragma unroll
            for (int d4 = 0; d4 < 4; ++d4) { const u32x4_t hv = *(const LAS u32x4_t*)(sl + 6144 + lane * 64 + d4 * 16); hq[4 * d4] = hv.x; hq[4 * d4 + 1] = hv.y; hq[4 * d4 + 2] = hv.z; hq[4 * d4 + 3] = hv.w; }
            gather_sweep<WRITE, MASK>(P, (LAS unsigned*)sl + g * 128, (LAS float*)(sl + 2048) + g * 128, (LAS float*)(sl + 4096) + g * 128, hq, sh, row, li, GT2L, FGL);
            asm volatile("s_waitcnt lgkmcnt(0)" ::: "memory");
            if (lane == 0) FLG[4 + r] = (unsigned)(sw + 1);
        }
    }
    __builtin_amdgcn_s_setprio(0);
    __syncthreads();
}
struct Args { Params p; };

template <class Epi> __device__ __forceinline__ void run_gemm(LAS unsigned char* lds, const bf16_t* A, const bf16_t* Bt, int N, const Epi& E, int bsel_tiles = 0) {
    pg8::Gemm g{A, Bt, NT, N, DM, bsel_tiles, SEQ / 256};
    pg8::StaticOrder S; S.init(NT, N, (int)gridDim.x, (int)blockIdx.x);
    pg8::gemm_phase<Epi, pg8::StaticOrder, true, true>(lds, g, S, E);
}

constexpr int CW_BAR = 1024;
__device__ __forceinline__ const Params* opaque_params() {
    auto k = __builtin_amdgcn_kernarg_segment_ptr();
    asm volatile("" : "+s"(k));
    return (const Params*)k;
}
__global__ void __launch_bounds__(NTHREADS, 2) mega_kernel(Args a) {
    extern __shared__ __attribute__((aligned(16))) unsigned char smem[];
    LAS unsigned char* lds = (LAS unsigned char*)smem;
    const int vb = blockIdx.x, G = gridDim.x;
    if (threadIdx.x < 128) ((LAS unsigned*)(lds + MISC_OFF))[threadIdx.x] = 0u;
    __syncthreads();
    XcdBarrier bar = xcd_barrier_post((unsigned*)(a.p.ws + WS_CTL) + CW_BAR, (volatile LAS unsigned*)(lds + MISC_OFF) + 8);
#define GRID_BAR() xcd_barrier(bar)
#define LOADP() const Params P = *opaque_params(); unsigned char* ws = P.ws; const float* MOD = (const float*)(ws + WS_MOD); (void)MOD
    { LOADP(); phase_prep(P, lds, vb, G); }
    GRID_BAR();
    { LOADP(); phase_normmod(P.x, nullptr, P.norm1_g, MOD, 0, 1024, (bf16_t*)(ws + WS_H), vb, G); phase_wpk_batch(P, vb, G); }
    GRID_BAR();
    { LOADP(); EpiProj E{(bf16_t*)(ws + WS_PROJ), (float*)(ws + WS_LOGA), P.b_gla_alpha}; run_gemm(lds, (const bf16_t*)(ws + WS_H), (const bf16_t*)(ws + WS_WTIN), NPAD, E); }
    GRID_BAR();
    { LOADP(); if (vb & 1) { phase_swa(P, lds, vb, G); phase_gla<false>(P, lds, vb, G); } else { phase_gla<false>(P, lds, vb, G); phase_swa(P, lds, vb, G); } }
    GRID_BAR();
    { LOADP(); phase_gla<true>(P, lds, vb, G); }
    GRID_BAR();
    { LOADP(); EpiOut E{P.x, MOD, (bf16_t*)(ws + WS_X1), (float*)(ws + WS_SSQ2)}; run_gemm(lds, (const bf16_t*)(ws + WS_OMIX), (const bf16_t*)(ws + WS_WTOUT), DM, E); }
    GRID_BAR();
    { LOADP(); EpiKey E{(unsigned*)(ws + WS_SKEY), (const float*)(ws + WS_SSQ2), (const float*)(ws + WS_CB)}; run_gemm(lds, (const bf16_t*)(ws + WS_X1), (const bf16_t*)(ws + WS_WTPKB), 2048, E, 8); }
    GRID_BAR();
    { LOADP(); phase_peer3<true>(P, lds, vb, G); }
}

extern "C" void kernel_launch(void* const* d_in, const int* in_sizes, int n_in, void* d_out, int out_size, void* d_ws, size_t ws_size, hipStream_t stream) {
    static int ready = 0;
    if (ready == 0) {
        if (n_in != 19 || out_size != NT * DM || ws_size < WS_END) { fprintf(stderr, "kernel_launch: unexpected sizes n_in %d out %d ws %zu\n", n_in, out_size, ws_size); ready = -1; return; }
        if (hipFuncSetAttribute((const void*)mega_kernel, hipFuncAttributeMaxDynamicSharedMemorySize, LDS_BYTES) != hipSuccess) { fprintf(stderr, "kernel_launch: hipFuncSetAttribute failed\n"); ready = -1; return; }
        ready = 1;
    }
    if (ready < 0) return;
    Args a{};
    const float** pp = (const float**)&a.p;
    for (int i = 0; i < 19; ++i) pp[i] = (const float*)d_in[i];
    a.p.out = (float*)d_out; a.p.ws = (unsigned char*)d_ws;
    if (hipMemsetAsync((char*)d_ws + WS_CTL, 0, CTL_ZERO_BYTES, stream) != hipSuccess) { fprintf(stderr, "kernel_launch: memset failed\n"); return; }
    hipLaunchKernelGGL(mega_kernel, dim3(256), dim3(NTHREADS), LDS_BYTES, stream, a);
}
```

```cpp
#include <hip/hip_runtime.h>
#include <cstdio>
#include <cstdint>
#include <cmath>

constexpr int DM = 1024, NB = 4, SEQ = 8192, NT = NB * SEQ;
constexpr int GLA_H = 4, GLA_DK = 64, GLA_DV = 128, GLA_RANK = 16, GLA_CHUNK = 64;
constexpr int SWA_H = 8, SWA_KV = 2, SWA_HD = 64, SWA_W = 128;
constexpr int PEER_H = 8, PEER_NK = 128, PEER_NE = PEER_NK * PEER_NK, PEER_QD = 256, PEER_K = 16;
constexpr int IN_W = 2320;
constexpr float RMS_EPS = 1e-6f;
constexpr int PROJ_W = 2304, NPAD = 2560;
constexpr int C_QG = 0, C_KG = 256, C_VG = 512, C_RG = 1024, C_QS = 1536, C_KS = 2048, C_VS = 2176;
constexpr int NTHREADS = 512, NWAVES = 8;
constexpr int LDS_BYTES = 163840;
constexpr int MISC_OFF = LDS_BYTES - 512;

constexpr size_t MiB = 1u << 20;
constexpr size_t WS_CTL = 0, CTL_ZERO_BYTES = 64 * 1024;
constexpr size_t WS_MOD = 1 * MiB;
constexpr size_t WS_WTIN = 2 * MiB;
constexpr size_t WS_WTOUT = 7 * MiB;
constexpr size_t WS_WTPK = 9 * MiB;
constexpr size_t WS_GU = 13 * MiB;
constexpr size_t WS_GD = 21 * MiB;
constexpr size_t WS_USC = 21 * MiB + 256 * 1024, WS_VSC = WS_USC + 65536;
constexpr size_t WS_UBF = 22 * MiB;
constexpr size_t WS_VBF = 54 * MiB;
constexpr size_t WS_H = 86 * MiB;
constexpr size_t WS_PROJ = 150 * MiB;
constexpr size_t WS_LOGA = 294 * MiB;
constexpr size_t WS_OMIX = 326 * MiB;
constexpr size_t WS_SKEY = 150 * MiB;
constexpr size_t WS_X1 = 406 * MiB;
constexpr size_t WS_WPF = 470 * MiB;
constexpr size_t WS_WTPKB = 478 * MiB;
constexpr size_t WS_CB = 1 * MiB + 128 * 1024;
constexpr size_t WS_SSQ2 = 38 * MiB;
constexpr size_t WS_END = 494 * MiB;

typedef unsigned short bf16_t;
typedef unsigned u32x4_t __attribute__((ext_vector_type(4)));
typedef unsigned u32x2_t __attribute__((ext_vector_type(2)));
typedef float f32x4_t __attribute__((ext_vector_type(4)));
#define LAS __attribute__((address_space(3)))
#define GAS __attribute__((address_space(1)))

struct Params {
    const float *x, *c, *w_ada, *b_ada, *norm1_g, *norm2_g, *w_in, *w_gla_alpha, *b_gla_alpha, *gla_norm_g, *swa_sinks, *swa_norm_g, *w_out, *w_peer_q,
        *peer_keys_1, *peer_keys_2, *peer_u, *peer_v, *final_g;
    float* out; unsigned char* ws;
};

__device__ __forceinline__ float bf2f(unsigned v) { return __uint_as_float(v << 16); }
__device__ __forceinline__ float bflo(unsigned w) { return __uint_as_float(w << 16); }
__device__ __forceinline__ float bfhi(unsigned w) { return __uint_as_float(w & 0xffff0000u); }
typedef float f32x2_t __attribute__((ext_vector_type(2))); typedef __bf16 bf16x2_t __attribute__((ext_vector_type(2)));
__device__ __forceinline__ unsigned pk2(float lo, float hi) { const f32x2_t v = {lo, hi}; return __builtin_bit_cast(unsigned, __builtin_convertvector(v, bf16x2_t)); }
__device__ __forceinline__ unsigned f2bf(float f) { return pk2(f, 0.f) & 0xffffu; }
__device__ __forceinline__ float wave_sum(float v) {
#pragma unroll
    for (int o = 1; o < 64; o <<= 1) v += __shfl_xor(v, o);
    return v;
}
__device__ __forceinline__ float silu_f(float v) { return v / (1.f + __expf(-v)); }
__device__ __forceinline__ unsigned f2key(float f) { unsigned u = __float_as_uint(f); return u ^ ((u >> 31) ? 0xffffffffu : 0x80000000u); }
__device__ __forceinline__ float key2f(unsigned k) { unsigned u = k ^ ((k >> 31) ? 0x80000000u : 0xffffffffu); return __uint_as_float(u); }

__device__ __forceinline__ int opaque_tid() { int t = threadIdx.x; asm volatile("" : "+v"(t)); return t; }
__device__ __forceinline__ void insert16(unsigned (&L)[16], unsigned x) {
#pragma unroll
    for (int j = 0; j < 16; ++j) { const unsigned hi = L[j] > x ? L[j] : x; x = L[j] > x ? x : L[j]; L[j] = hi; }
}
__device__ __forceinline__ void cex(unsigned& a, unsigned& b) { const unsigned hi = a > b ? a : b, lo = a > b ? b : a; a = hi; b = lo; }
__device__ __forceinline__ void bitonic_merge16(unsigned (&v)[16]) {
#pragma unroll
    for (int j = 8; j >= 1; j >>= 1)
#pragma unroll
        for (int i = 0; i < 16; ++i) if ((i & j) == 0) cex(v[i], v[i | j]);
}
__device__ __forceinline__ void sort16_desc(unsigned (&v)[16]) {
#pragma unroll
    for (int k = 2; k <= 16; k <<= 1)
#pragma unroll
        for (int j = k >> 1; j >= 1; j >>= 1)
#pragma unroll
            for (int i = 0; i < 16; ++i) { const int l = i ^ j; if (l > i) { if ((i & k) == 0 || k == 16) cex(v[i], v[l]); else cex(v[l], v[i]); } }
}
__device__ __forceinline__ void merge_top16(unsigned (&L)[16], const unsigned (&N)[16]) {
#pragma unroll
    for (int i = 0; i < 16; ++i) L[i] = L[i] > N[15 - i] ? L[i] : N[15 - i];
    bitonic_merge16(L);
}
__device__ __forceinline__ int row_sum16_i(int v) {
    v += __builtin_amdgcn_mov_dpp(v, 0x128, 0xf, 0xf, false); v += __builtin_amdgcn_mov_dpp(v, 0x124, 0xf, 0xf, false);
    v += __builtin_amdgcn_mov_dpp(v, 0x122, 0xf, 0xf, false); v += __builtin_amdgcn_mov_dpp(v, 0x121, 0xf, 0xf, false); return v;
}
__device__ __forceinline__ float row_sum16_f(float v) {
    v += __builtin_bit_cast(float, __builtin_amdgcn_mov_dpp(__builtin_bit_cast(int, v), 0x128, 0xf, 0xf, false)); v += __builtin_bit_cast(float, __builtin_amdgcn_mov_dpp(__builtin_bit_cast(int, v), 0x124, 0xf, 0xf, false));
    v += __builtin_bit_cast(float, __builtin_amdgcn_mov_dpp(__builtin_bit_cast(int, v), 0x122, 0xf, 0xf, false)); v += __builtin_bit_cast(float, __builtin_amdgcn_mov_dpp(__builtin_bit_cast(int, v), 0x121, 0xf, 0xf, false)); return v;
}
__device__ __forceinline__ float row_max16_f(float v) {
    v = fmaxf(v, __builtin_bit_cast(float, __builtin_amdgcn_mov_dpp(__builtin_bit_cast(int, v), 0x128, 0xf, 0xf, false))); v = fmaxf(v, __builtin_bit_cast(float, __builtin_amdgcn_mov_dpp(__builtin_bit_cast(int, v), 0x124, 0xf, 0xf, false)));
    v = fmaxf(v, __builtin_bit_cast(float, __builtin_amdgcn_mov_dpp(__builtin_bit_cast(int, v), 0x122, 0xf, 0xf, false))); v = fmaxf(v, __builtin_bit_cast(float, __builtin_amdgcn_mov_dpp(__builtin_bit_cast(int, v), 0x121, 0xf, 0xf, false))); return v;
}
__device__ __forceinline__ float dpp_swap1_f(float v) { return __builtin_bit_cast(float, __builtin_amdgcn_mov_dpp(__builtin_bit_cast(int, v), 0xB1, 0xf, 0xf, false)); }
__device__ __forceinline__ unsigned wave_incl_scan_u32(unsigned v) {
    v += (unsigned)__builtin_amdgcn_update_dpp(0, (int)v, 0x111, 0xf, 0xf, false); v += (unsigned)__builtin_amdgcn_update_dpp(0, (int)v, 0x112, 0xf, 0xf, false);
    v += (unsigned)__builtin_amdgcn_update_dpp(0, (int)v, 0x114, 0xf, 0xf, false); v += (unsigned)__builtin_amdgcn_update_dpp(0, (int)v, 0x118, 0xf, 0xf, false);
    v += (unsigned)__builtin_amdgcn_update_dpp(0, (int)v, 0x142, 0xa, 0xf, false); v += (unsigned)__builtin_amdgcn_update_dpp(0, (int)v, 0x143, 0xc, 0xf, false); return v;
}
__device__ __forceinline__ float row_ssq16(const float* p) {
    const f32x4_t a = *(const f32x4_t*)p, b = *(const f32x4_t*)(p + 4), c = *(const f32x4_t*)(p + 8), d = *(const f32x4_t*)(p + 12);
    return (((a[0] + a[1]) + (a[2] + a[3])) + ((b[0] + b[1]) + (b[2] + b[3]))) + (((c[0] + c[1]) + (c[2] + c[3])) + ((d[0] + d[1]) + (d[2] + d[3])));
}
namespace pg8 {
#define PG8_LAS __attribute__((address_space(3)))
typedef unsigned short bf16_t;
typedef short bf16x8 __attribute__((ext_vector_type(8)));
typedef float f32x4 __attribute__((ext_vector_type(4)));
typedef unsigned u32x4 __attribute__((ext_vector_type(4)));
constexpr int BM = 256, BK = 64, HALF = 128, HTB = HALF * BK * 2  , STAGE_BYTES = 8 * HTB, NXCD = 8, WGM = 8;

__host__ __device__ __forceinline__ int lds_byte(int r, int c) { const int st = (r >> 4) * 2 + (c >> 5), rr = r & 15, cc = c & 31, ob = rr * 64 + cc * 2; return st * 1024 + (ob ^ (((ob >> 9) & 1) << 5)); }
__host__ __device__ __forceinline__ void stage_rc(int b, int& R, int& C) { const int st = b / 1024, sb = b % 1024, swz = sb ^ (((sb >> 9) & 1) << 5); R = (st >> 1) * 16 + swz / 64; C = (st & 1) * 32 + (swz % 64) / 2; }
__host__ __device__ __forceinline__ int perm32(int rho) { const int n = rho >> 4, i = rho & 15; return 8 * (i >> 2) + 4 * n + (i & 3); }

struct Unit { int pm, pn; };
struct Gemm { const bf16_t* A; const bf16_t* Bt; int M, N, K; int bsel_tiles, bsel_pm; };

struct StaticOrder {
    int nM, nN, nwg, G, c;
    __host__ __device__ void init(int M, int N, int G_, int c_) { nM = M / BM; nN = N / BM; nwg = nM * nN; G = G_; c = c_; }
    __host__ __device__ bool next(int i, Unit& u) const {
        const long L = (long)i * G + c; if (L >= nwg) return false;
        int wgid = (int)L; { const int q = nwg / NXCD, r = nwg % NXCD, xcd = wgid % NXCD, off = wgid / NXCD; wgid = (xcd < r ? xcd * (q + 1) : r * (q + 1) + (xcd - r) * q) + off; }
        const int nig = WGM * nN, gid = wgid / nig, fm = gid * WGM, gsz = (nM - fm) < WGM ? (nM - fm) : WGM;
        u.pm = fm + ((wgid % nig) % gsz); u.pn = (wgid % nig) / gsz; return true;
    }
    __device__ __forceinline__ void a_ready(const Unit&) const {}
    __device__ __forceinline__ void done(const Unit&) const {}
};

__device__ __forceinline__ unsigned cvt_pk_bf16(float lo, float hi) { unsigned r; asm volatile("v_cvt_pk_bf16_f32 %0, %1, %2" : "=v"(r) : "v"(lo), "v"(hi)); return r; }
typedef float f32x2 __attribute__((ext_vector_type(2)));
template <class Epi, class Sched, bool ALIGN_EPI = false, bool SP2 = false>
__device__ __forceinline__ void gemm_phase(PG8_LAS unsigned char* lds, const Gemm g, const Sched& S, const Epi& E) {
    const int tid = opaque_tid(), wid = __builtin_amdgcn_readfirstlane(tid >> 6), lane = tid & 63, wr = wid >> 2, wc = wid & 3, fr = lane & 15, fq = lane >> 4;
    const int K = g.K, nt = K / BK;
    unsigned voffA[2], voffB[2];
#pragma unroll
    for (int i = 0; i < 2; ++i) { int R, C; stage_rc(tid * 16 + i * 8192, R, C); const int Rb = Epi::PERM ? ((R & ~31) + perm32(R & 31)) : R;
        voffA[i] = (unsigned)(R * K + C) * 2u; voffB[i] = (unsigned)(Rb * K + C) * 2u; }
    const size_t kstep = (size_t)(BK * 2);
    const size_t hstep = (size_t)HALF * K * 2;
    const size_t tstep = 2 * hstep;
    const unsigned ldsw = (unsigned)wid * 1024u;
    const int aoff = lds_byte(wr * 64 + fr, fq * 8), boff = lds_byte(wc * 32 + fr, fq * 8);
#define PG8_SA(b, h) (((b) * 2 + (h)) * HTB)
#define PG8_SB(b, h) ((4 + (b) * 2 + (h)) * HTB)
#define PG8_STAGE(bufoff, gbase, voff) do { _Pragma("unroll") for (int _i = 0; _i < 2; ++_i) \
        __builtin_amdgcn_global_load_lds((const unsigned*)((const char*)(gbase) + (voff)[_i]), (PG8_LAS unsigned*)(lds + (bufoff) + ldsw + _i * 8192), 16, 0, 0); } while (0)
#define PG8_LDA(dst, b, h) do { _Pragma("unroll") for (int m = 0; m < 4; ++m) _Pragma("unroll") for (int k = 0; k < 2; ++k) dst[m][k] = *(const PG8_LAS bf16x8*)(lds + PG8_SA(b, h) + aoff + m * 2048 + k * 1024); } while (0)
#define PG8_LDB(dst, b, h) do { _Pragma("unroll") for (int n = 0; n < 2; ++n) _Pragma("unroll") for (int k = 0; k < 2; ++k) dst[n][k] = *(const PG8_LAS bf16x8*)(lds + PG8_SB(b, h) + boff + n * 2048 + k * 1024); } while (0)
#define PG8_MMA(ai, bj, At, Bt) do { __builtin_amdgcn_s_setprio(1); _Pragma("unroll") for (int m = 0; m < 4; ++m) _Pragma("unroll") for (int n = 0; n < 2; ++n) _Pragma("unroll") for (int k = 0; k < 2; ++k) \
        acc[ai][bj][m][n] = __builtin_amdgcn_mfma_f32_16x16x32_bf16(Bt[n][k], At[m][k], acc[ai][bj][m][n], 0, 0, 0); __builtin_amdgcn_s_setprio(0); } while (0)
#define PG8_WAIT_V(n) asm volatile("s_waitcnt vmcnt(" #n ")" ::: "memory")
#define PG8_WAIT_L(n) asm volatile("s_waitcnt lgkmcnt(" #n ")" ::: "memory")
#define PG8_BAR __builtin_amdgcn_s_barrier()
#define PG8_SCHED __builtin_amdgcn_sched_barrier(0)
    Unit cur, nxt; int ui = 0;
    if (!S.next(0, cur)) return;
    f32x4 acc[2][2][4][2];
#pragma unroll
    for (int a = 0; a < 2; ++a)
#pragma unroll
        for (int b = 0; b < 2; ++b)
#pragma unroll
            for (int m = 0; m < 4; ++m)
#pragma unroll
                for (int n = 0; n < 2; ++n) acc[a][b][m][n] = (f32x4){0.f, 0.f, 0.f, 0.f};
    bf16x8 At[4][2], B0[2][2], B1[2][2];
    const char* cA = (const char*)g.A + (size_t)cur.pm * tstep; const char* cB = (const char*)g.Bt + (size_t)(cur.pn + (g.bsel_tiles ? g.bsel_tiles * (cur.pm / g.bsel_pm) : 0)) * tstep;
    S.a_ready(cur);
    if constexpr (SP2) {
        PG8_STAGE(PG8_SB(0, 0), cB, voffB); PG8_STAGE(PG8_SB(0, 1), cB + hstep, voffB); PG8_STAGE(PG8_SA(0, 0), cA, voffA); PG8_STAGE(PG8_SA(0, 1), cA + hstep, voffA);
        if (wr == 1) PG8_BAR;
        PG8_WAIT_V(2); PG8_BAR;
        PG8_STAGE(PG8_SB(1, 0), cB + kstep, voffB); PG8_STAGE(PG8_SA(1, 0), cA + kstep, voffA); PG8_STAGE(PG8_SB(1, 1), cB + hstep + kstep, voffB);
        PG8_WAIT_V(6); PG8_BAR;
    } else {
        PG8_STAGE(PG8_SB(0, 0), cB, voffB); PG8_STAGE(PG8_SA(0, 0), cA, voffA); PG8_STAGE(PG8_SB(0, 1), cB + hstep, voffB); PG8_STAGE(PG8_SA(0, 1), cA + hstep, voffA);
        if (wr == 1) PG8_BAR;
        PG8_WAIT_V(4); PG8_BAR;
        PG8_STAGE(PG8_SB(1, 0), cB + kstep, voffB); PG8_STAGE(PG8_SA(1, 0), cA + kstep, voffA); PG8_STAGE(PG8_SB(1, 1), cB + hstep + kstep, voffB);
        PG8_WAIT_V(6); PG8_BAR;
    }
    for (;;) {
        const bool has_next = S.next(ui + 1, nxt);
        const char* nA = has_next ? (const char*)g.A + (size_t)nxt.pm * tstep : cA; const char* nB = has_next ? (const char*)g.Bt + (size_t)(nxt.pn + (g.bsel_tiles ? g.bsel_tiles * (nxt.pm / g.bsel_pm) : 0)) * tstep : cB;
        for (int t = 0; t < nt; t += 2) {
            const bool last = (t == nt - 2);
            const char* a1 = cA + (size_t)(t + 1) * kstep;
            const char* a2 = last ? nA : cA + (size_t)(t + 2) * kstep; const char* b2 = last ? nB : cB + (size_t)(t + 2) * kstep;
            const char* a3 = a2 + kstep; const char* b3 = b2 + kstep;
            if (last && has_next) S.a_ready(nxt);
            if constexpr (SP2) {
            PG8_LDB(B0, 0, 0); PG8_LDB(B1, 0, 1); PG8_SCHED; PG8_LDA(At, 0, 0); PG8_STAGE(PG8_SA(1, 1), a1 + hstep, voffA);
            PG8_WAIT_V(8); PG8_WAIT_L(0); PG8_BAR; PG8_MMA(0, 0, At, B0); PG8_MMA(0, 1, At, B1); PG8_BAR; PG8_SCHED;
            PG8_LDA(At, 0, 1); PG8_STAGE(PG8_SB(0, 0), b2, voffB); PG8_STAGE(PG8_SB(0, 1), b2 + hstep, voffB); PG8_STAGE(PG8_SA(0, 0), a2, voffA);
            PG8_WAIT_V(8); PG8_WAIT_L(0); PG8_BAR; PG8_MMA(1, 0, At, B0); PG8_MMA(1, 1, At, B1); PG8_BAR; PG8_SCHED;
            PG8_LDB(B0, 1, 0); PG8_LDB(B1, 1, 1); PG8_SCHED; PG8_LDA(At, 1, 0); PG8_STAGE(PG8_SA(0, 1), a2 + hstep, voffA);
            PG8_WAIT_V(8); PG8_WAIT_L(0); PG8_BAR; PG8_MMA(0, 0, At, B0); PG8_MMA(0, 1, At, B1); PG8_BAR; PG8_SCHED;
            PG8_LDA(At, 1, 1); PG8_STAGE(PG8_SB(1, 0), b3, voffB); PG8_STAGE(PG8_SB(1, 1), b3 + hstep, voffB); PG8_STAGE(PG8_SA(1, 0), a3, voffA);
            PG8_WAIT_V(8); PG8_WAIT_L(0); PG8_BAR; PG8_MMA(1, 0, At, B0); PG8_MMA(1, 1, At, B1); PG8_BAR; PG8_SCHED;
            } else {
            PG8_LDB(B0, 0, 0); PG8_SCHED; PG8_LDA(At, 0, 0); PG8_STAGE(PG8_SA(1, 1), a1 + hstep, voffA);
            PG8_WAIT_L(8); PG8_BAR; PG8_WAIT_L(0); PG8_MMA(0, 0, At, B0); PG8_BAR; PG8_SCHED;
            PG8_LDB(B1, 0, 1); PG8_STAGE(PG8_SB(0, 0), b2, voffB);
            PG8_BAR; PG8_WAIT_L(0); PG8_MMA(0, 1, At, B1); PG8_BAR;
            PG8_LDA(At, 0, 1); PG8_STAGE(PG8_SA(0, 0), a2, voffA);
            PG8_BAR; PG8_WAIT_L(0); PG8_MMA(1, 0, At, B0); PG8_BAR; PG8_SCHED;
            PG8_STAGE(PG8_SB(0, 1), b2 + hstep, voffB);
            PG8_WAIT_V(6); PG8_BAR; PG8_MMA(1, 1, At, B1); PG8_BAR;
            PG8_LDB(B0, 1, 0); PG8_SCHED; PG8_LDA(At, 1, 0); PG8_STAGE(PG8_SA(0, 1), a2 + hstep, voffA);
            PG8_WAIT_L(8); PG8_BAR; PG8_WAIT_L(0); PG8_MMA(0, 0, At, B0); PG8_BAR; PG8_SCHED;
            PG8_LDB(B1, 1, 1); PG8_STAGE(PG8_SB(1, 0), b3, voffB);
            PG8_BAR; PG8_WAIT_L(0); PG8_MMA(0, 1, At, B1); PG8_BAR;
            PG8_LDA(At, 1, 1); PG8_STAGE(PG8_SA(1, 0), a3, voffA);
            PG8_BAR; PG8_WAIT_L(0); PG8_MMA(1, 0, At, B0); PG8_BAR; PG8_SCHED;
            PG8_STAGE(PG8_SB(1, 1), b3 + hstep, voffB);
            PG8_WAIT_V(6); PG8_BAR; PG8_MMA(1, 1, At, B1); PG8_BAR;
            }
        }
        if constexpr (ALIGN_EPI) { if (wr == 0) PG8_BAR; }
        if constexpr (!Epi::AFTER_DRAIN) { E(acc, cur, wr, wc, fr, fq); S.done(cur); }
        if (!has_next) break;
#pragma unroll
        for (int a = 0; a < 2; ++a)
#pragma unroll
            for (int b = 0; b < 2; ++b)
#pragma unroll
                for (int m = 0; m < 4; ++m)
#pragma unroll
                    for (int n = 0; n < 2; ++n) acc[a][b][m][n] = (f32x4){0.f, 0.f, 0.f, 0.f};
        cur = nxt; cA = nA; cB = nB; ++ui;
        if constexpr (ALIGN_EPI) { if (wr == 1) PG8_BAR; }
    }
    PG8_WAIT_V(0);
    if constexpr (!ALIGN_EPI) { if (wr == 0) PG8_BAR; }
    PG8_BAR;
    if constexpr (Epi::AFTER_DRAIN) { E.fused(acc, cur, wr, wc, fr, fq, lds, wid, lane); S.done(cur); }
#undef PG8_SA
#undef PG8_SB
#undef PG8_STAGE
#undef PG8_LDA
#undef PG8_LDB
#undef PG8_MMA
#undef PG8_WAIT_V
#undef PG8_WAIT_L
#undef PG8_BAR
#undef PG8_SCHED
}
}
typedef GAS unsigned gu32;
typedef GAS unsigned long long gu64;
#define RLX_AGENT __ATOMIC_RELAXED, __HIP_MEMORY_SCOPE_AGENT
#define LDS_WAIT() asm volatile("s_waitcnt lgkmcnt(0)" ::: "memory")
#define VM_WAIT() asm volatile("s_waitcnt vmcnt(0)" ::: "memory")
__device__ __forceinline__ unsigned long long rt() { return __builtin_amdgcn_s_memrealtime(); }
#define XB_TMO      128
#define XB_XCNT(j)  (256  + 64 * (j))
#define XB_XSUB(j)  (1280 + 64 * (j))
#define XB_XGEN(j)  (2304 + 64 * (j))
#define XB_TOP      3328
#define XB_TOPGEN   3392
#define XCD_BAR_WORDS 3456
#define XB_SPIN_CAP (1u << 18)

__device__ __forceinline__ unsigned xb_ld(unsigned* p)              { return __hip_atomic_load(p, __ATOMIC_RELAXED, __HIP_MEMORY_SCOPE_AGENT); }
__device__ __forceinline__ unsigned xb_add(unsigned* p, unsigned v) { return __hip_atomic_fetch_add(p, v, __ATOMIC_RELAXED, __HIP_MEMORY_SCOPE_AGENT); }
__device__ __forceinline__ unsigned xb_xcc_id() { return (unsigned)__builtin_amdgcn_s_getreg((3 << 11) | 20) & 0xFu; }
#define XB_SPIN(cond, bar) do { unsigned _sp = 0; while (cond) { __builtin_amdgcn_s_sleep(1); \
    if ((++_sp & 255u) == 0u) { if (xb_ld(&(bar)[XB_TMO])) break; if (_sp > XB_SPIN_CAP) { atomicAdd(&(bar)[XB_TMO], 1u); break; } } } } while (0)

struct XcdBarrier {
    unsigned* bar; unsigned x;
    volatile LAS unsigned* st;
};

__device__ __forceinline__ XcdBarrier xcd_barrier_post(unsigned* bar, volatile LAS unsigned* st) {
    XcdBarrier b; b.bar = bar; b.x = xb_xcc_id(); b.st = st;
    if (threadIdx.x == 0) (void)xb_add(&bar[XB_XCNT(b.x)], 1u);
    return b;
}
__device__ __forceinline__ void xcd_barrier_complete(unsigned* bar, unsigned x, unsigned& nloc, unsigned& nx) {
    const unsigned G = gridDim.x * gridDim.y * gridDim.z;
    unsigned sum, cnt, mine, sp = 0u;
    for (;;) {
        sum = 0u; cnt = 0u; mine = 0u;
#pragma unroll
        for (unsigned j = 0; j < 16; ++j) { const unsigned c = xb_ld(&bar[XB_XCNT(j)]); sum += c; cnt += (c > 0u) ? 1u : 0u; mine = (j == x) ? c : mine; }
        if (sum == G) break;
        __builtin_amdgcn_s_sleep(1);
        if ((++sp & 255u) == 0u) { if (xb_ld(&bar[XB_TMO])) break; if (sp > XB_SPIN_CAP) { atomicAdd(&bar[XB_TMO], 1u); break; } }
    }
    nloc = mine > 0u ? mine : 1u; nx = cnt > 0u ? cnt : 1u;
}

__device__ __forceinline__ void xcd_barrier(const XcdBarrier& b) {
    asm volatile("s_waitcnt vmcnt(0)" ::: "memory");
    __syncthreads();
    if (threadIdx.x == 0) {
        unsigned* bar = b.bar;
        __builtin_amdgcn_s_waitcnt(0);
        unsigned nloc = b.st[0], nx = b.st[1];
        if (nloc == 0u) { xcd_barrier_complete(bar, b.x, nloc, nx); b.st[0] = nloc; b.st[1] = nx; }
        const unsigned old = xb_add(&bar[XB_XSUB(b.x)], 1u);
        const unsigned gen = old / nloc;
        if (old + 1u == (gen + 1u) * nloc) {
            __builtin_amdgcn_fence(__ATOMIC_RELEASE, "agent");
            asm volatile("s_waitcnt vmcnt(0)" ::: "memory");
            const unsigned og = xb_add(&bar[XB_TOP], 1u);
            const unsigned tg = og / nx;
            if (og + 1u == (tg + 1u) * nx) xb_add(&bar[XB_TOPGEN], 1u);
            else XB_SPIN(xb_ld(&bar[XB_TOPGEN]) == tg, bar);
            __builtin_amdgcn_fence(__ATOMIC_ACQUIRE, "agent");
            xb_add(&bar[XB_XGEN(b.x)], 1u);
            asm volatile("s_waitcnt vmcnt(0)" ::: "memory");
        } else {
            XB_SPIN(xb_ld(&bar[XB_XGEN(b.x)]) == gen, bar);
            __builtin_amdgcn_fence(__ATOMIC_ACQUIRE, "agent");
            asm volatile("s_waitcnt vmcnt(0)" ::: "memory");
        }
    }
    __syncthreads();
}

typedef short bf16x8_t __attribute__((ext_vector_type(8)));
typedef short s16x4_t __attribute__((ext_vector_type(4)));
typedef float f32x16_t __attribute__((ext_vector_type(16)));
__device__ __forceinline__ s16x4_t lds_tr(const LAS unsigned char* p) { return __builtin_bit_cast(s16x4_t, __builtin_amdgcn_ds_read_tr16_b64_v4i16((LAS s16x4_t*)p)); }
__device__ __forceinline__ bf16x8_t cat8(s16x4_t lo, s16x4_t hi) { return (bf16x8_t){lo[0], lo[1], lo[2], lo[3], hi[0], hi[1], hi[2], hi[3]}; }
__device__ __forceinline__ void lds_st16(LAS unsigned char* p, float v) { *(LAS unsigned short*)p = (unsigned short)f2bf(v); }

constexpr int GL_QS = 0, GL_KS = 9216, GL_PS = 18432, GL_KH = 27648, GL_VS = 37888, GL_TOT = 56320, GL_DEC = 58368, GL_SSQ = 58624, GL_RSTD = 60672;
template <bool OUT> __device__ __forceinline__ void phase_gla(const Params& P, LAS unsigned char* lds, int vb, int G) {
    const int tid = opaque_tid(), lane = tid & 63, w = tid >> 6, n = lane & 15, g = lane >> 4, q_ = n >> 2, p_ = n & 3;
    const bf16_t* PROJ = (const bf16_t*)(P.ws + WS_PROJ); const _Float16* LOGA = (const _Float16*)(P.ws + WS_LOGA); bf16_t* OMIX = (bf16_t*)(P.ws + WS_OMIX);
    float* GU = (float*)(P.ws + WS_GU); float* GD = (float*)(P.ws + WS_GD);
    LAS float* TOT = (LAS float*)(lds + GL_TOT); LAS float* DEC = (LAS float*)(lds + GL_DEC); LAS float* SSQ = (LAS float*)(lds + GL_SSQ); LAS float* RSTD = (LAS float*)(lds + GL_RSTD);
    for (int item = vb; item < NB * GLA_H * 16; item += G) {
        const int b = item >> 6, h = (item >> 4) & 3, grp = item & 15; const size_t row0 = (size_t)b * SEQ + (size_t)grp * 512;
        f32x4_t S[4];
#pragma unroll
        for (int i = 0; i < 4; ++i) S[i] = (f32x4_t){0.f, 0.f, 0.f, 0.f};
        if (OUT) {
            for (int gp = 0; gp < grp; ++gp) { const float* U = GU + (size_t)(item - grp + gp) * 8192 + 16 * w + n; const float* Dv = GD + (size_t)(item - grp + gp) * 64;
#pragma unroll
                for (int i = 0; i < 4; ++i)
#pragma unroll
                    for (int r = 0; r < 4; ++r) { const int dk = 16 * i + 4 * g + r; S[i][r] = Dv[dk] * S[i][r] + U[dk * 128]; } }
        }
        float gdec = 1.f;
        const int ch = tid & 63, part = tid >> 6;
        float nla[8]; unsigned short nk[8], nq[8], nrg[16]; u32x4_t nv[2];
#define GLA_PREFETCH(rbase) do { const size_t rb_ = (rbase); \
            _Pragma("unroll") for (int i_ = 0; i_ < 8; ++i_) { const size_t row_ = rb_ + 8 * part + i_; nla[i_] = (float)LOGA[row_ * 256 + h * 64 + ch]; nk[i_] = PROJ[row_ * PROJ_W + C_KG + h * 64 + ch]; if (OUT) nq[i_] = PROJ[row_ * PROJ_W + C_QG + h * 64 + ch]; } \
            _Pragma("unroll") for (int j_ = 0; j_ < 2; ++j_) { const int idx_ = tid + 512 * j_; nv[j_] = *(const u32x4_t*)(PROJ + (rb_ + (idx_ >> 4)) * PROJ_W + C_VG + h * 128 + (idx_ & 15) * 8); } \
            if (OUT) { _Pragma("unroll") for (int tl_ = 0; tl_ < 4; ++tl_) _Pragma("unroll") for (int r_ = 0; r_ < 4; ++r_) nrg[4 * tl_ + r_] = PROJ[(rb_ + 16 * tl_ + 4 * g + r_) * PROJ_W + C_RG + h * 128 + 16 * w + n]; } } while (0)
        GLA_PREFETCH(row0);
        for (int c = 0; c < 8; ++c) {
            const size_t r0 = row0 + (size_t)c * 64;
            __syncthreads();
            float pre[8]; unsigned short kraw[8], qraw[8], rgraw[16];
#pragma unroll
            for (int i = 0; i < 8; ++i) { pre[i] = nla[i]; kraw[i] = nk[i]; if (OUT) qraw[i] = nq[i]; }
            if (OUT) {
#pragma unroll
                for (int i = 0; i < 16; ++i) rgraw[i] = nrg[i]; }
#pragma unroll
            for (int j = 0; j < 2; ++j) { const int idx = tid + 512 * j, t = idx >> 4, cc = idx & 15; *(LAS u32x4_t*)(lds + GL_VS + t * 288 + cc * 16) = nv[j]; }
            if (c + 1 < 8) { GLA_PREFETCH(r0 + 64); }
#pragma unroll
            for (int i = 1; i < 8; ++i) pre[i] += pre[i - 1];
            TOT[part * 64 + ch] = pre[7];
            __syncthreads();
            float off = 0.f, blast = 0.f;
#pragma unroll
            for (int p = 0; p < 8; ++p) { const float tv = TOT[p * 64 + ch]; blast += tv; if (p < part) off += tv; }
#pragma unroll
            for (int i = 0; i < 8; ++i) { const int t = 8 * part + i; const float bt = off + pre[i], kf = bf2f(kraw[i]);
                lds_st16(lds + GL_KH + t * 160 + ch * 2, kf * __expf(blast - bt));
                if (OUT) { lds_st16(lds + GL_QS + t * 144 + ch * 2, bf2f(qraw[i]) * __expf(bt)); lds_st16(lds + GL_KS + t * 144 + ch * 2, kf * __expf(-bt)); } }
            if (part == 0) { const float d = __expf(blast); DEC[ch] = d; gdec *= d; }
            __syncthreads();
            if (OUT) {
                const int tr = w >> 1;
#pragma unroll
                for (int tcn = 0; tcn < 2; ++tcn) { const int tc = 2 * (w & 1) + tcn; f32x4_t acc = {0.f, 0.f, 0.f, 0.f};
                    if (tc <= tr) {
#pragma unroll
                        for (int s = 0; s < 2; ++s) { const bf16x8_t a = *(const LAS bf16x8_t*)(lds + GL_QS + (16 * tr + n) * 144 + (32 * s + 8 * g) * 2), bb = *(const LAS bf16x8_t*)(lds + GL_KS + (16 * tc + n) * 144 + (32 * s + 8 * g) * 2);
                            acc = __builtin_amdgcn_mfma_f32_16x16x32_bf16(a, bb, acc, 0, 0, 0); } }
#pragma unroll
                    for (int r = 0; r < 4; ++r) { const int t = 16 * tr + 4 * g + r, s = 16 * tc + n; lds_st16(lds + GL_PS + t * 144 + s * 2, (tc <= tr && s <= t) ? acc[r] : 0.f); } }
                __syncthreads();
            }
            bf16x8_t vf[2];
#pragma unroll
            for (int s = 0; s < 2; ++s) vf[s] = cat8(lds_tr(lds + GL_VS + (32 * s + 8 * g + q_) * 288 + (16 * w + 4 * p_) * 2), lds_tr(lds + GL_VS + (32 * s + 8 * g + 4 + q_) * 288 + (16 * w + 4 * p_) * 2));
            f32x4_t O[4];
            if (OUT) {
                bf16x8_t sb[2];
#pragma unroll
                for (int s = 0; s < 2; ++s) { u32x4_t t4; t4.x = pk2(S[2 * s][0], S[2 * s][1]); t4.y = pk2(S[2 * s][2], S[2 * s][3]); t4.z = pk2(S[2 * s + 1][0], S[2 * s + 1][1]); t4.w = pk2(S[2 * s + 1][2], S[2 * s + 1][3]); sb[s] = __builtin_bit_cast(bf16x8_t, t4); }
#pragma unroll
                for (int tl = 0; tl < 4; ++tl) { f32x4_t o = {0.f, 0.f, 0.f, 0.f};
#pragma unroll
                    for (int s = 0; s < 2; ++s) { const LAS unsigned char* qp = lds + GL_QS + (16 * tl + n) * 144 + (32 * s + 4 * g) * 2;
                        const bf16x8_t aq = cat8(*(const LAS s16x4_t*)qp, *(const LAS s16x4_t*)(qp + 32)); o = __builtin_amdgcn_mfma_f32_16x16x32_bf16(aq, sb[s], o, 0, 0, 0); }
#pragma unroll
                    for (int s = 0; s < 2; ++s) { const bf16x8_t ap = *(const LAS bf16x8_t*)(lds + GL_PS + (16 * tl + n) * 144 + (32 * s + 8 * g) * 2); o = __builtin_amdgcn_mfma_f32_16x16x32_bf16(ap, vf[s], o, 0, 0, 0); }
                    O[tl] = o; }
            }
#pragma unroll
            for (int i = 0; i < 4; ++i) {
#pragma unroll
                for (int r = 0; r < 4; ++r) S[i][r] *= DEC[16 * i + 4 * g + r];
#pragma unroll
                for (int s = 0; s < 2; ++s) { const bf16x8_t ak = cat8(lds_tr(lds + GL_KH + (32 * s + 8 * g + q_) * 160 + (16 * i + 4 * p_) * 2), lds_tr(lds + GL_KH + (32 * s + 8 * g + 4 + q_) * 160 + (16 * i + 4 * p_) * 2));
                    S[i] = __builtin_amdgcn_mfma_f32_16x16x32_bf16(ak, vf[s], S[i], 0, 0, 0); } }
            if (OUT) {
#pragma unroll
                for (int tl = 0; tl < 4; ++tl)
#pragma unroll
                    for (int r = 0; r < 4; ++r) { float v = row_sum16_f(O[tl][r] * O[tl][r]);
                        if (n == 0) SSQ[w * 64 + 16 * tl + 4 * g + r] = v; }
                __syncthreads();
                if (tid < 64) { float tv = 0.f;
#pragma unroll
                    for (int ww = 0; ww < 8; ++ww) tv += SSQ[ww * 64 + tid];
                    RSTD[tid] = rsqrtf(tv * (1.f / GLA_DV) + RMS_EPS); }
                __syncthreads();
                const int col = h * 128 + 16 * w + n; const float gain = P.gla_norm_g[col];
#pragma unroll
                for (int tl = 0; tl < 4; ++tl)
#pragma unroll
                    for (int r = 0; r < 4; ++r) { const int t = 16 * tl + 4 * g + r; const float rg = bf2f(rgraw[4 * tl + r]);
                        OMIX[(r0 + t) * DM + col] = (bf16_t)f2bf(O[tl][r] * RSTD[t] * gain * silu_f(rg)); }
            }
        }
#undef GLA_PREFETCH
        if (!OUT) {
#pragma unroll
            for (int i = 0; i < 4; ++i)
#pragma unroll
                for (int r = 0; r < 4; ++r) GU[(size_t)item * 8192 + (16 * i + 4 * g + r) * 128 + 16 * w + n] = S[i][r];
            if (part == 0) GD[(size_t)item * 64 + ch] = gdec;
        }
    }
}

constexpr int SW_K = 0, SW_V = 2 * 256 * 144, SW_SSQ = SW_V + 2 * 256 * 128, SW_RL = SW_SSQ + 512, SW_END = SW_RL + 8 * 32 * 4;
static_assert(SW_END <= MISC_OFF, "SWA LDS map");
__device__ __forceinline__ void phase_swa(const Params& P, LAS unsigned char* lds, int vb, int G) {
    const int tid = opaque_tid(), lane = tid & 63, w = tid >> 6, a = lane & 31, hi = lane >> 5;
    const bf16_t* PROJ = (const bf16_t*)(P.ws + WS_PROJ); bf16_t* OMIX = (bf16_t*)(P.ws + WS_OMIX);
    LAS float* SSQ = (LAS float*)(lds + SW_SSQ);
    const int kvh = w >> 2;
    const float slope2 = exp2f(-(float)(w + 1)) * 1.4426950408889634f, sink2 = P.swa_sinks[w] * 1.4426950408889634f;
    for (int item = vb; item < NT / 128; item += G) {
        const size_t row0 = (size_t)item * 128; const int nb = item & 63;
        __syncthreads();
#pragma unroll 4
        for (int j = 0; j < 16; ++j) { const int idx = tid + 512 * j, isv = idx >> 12, kv = (idx >> 11) & 1, kj = (idx >> 3) & 255, cc = idx & 7;
            u32x4_t v = {0u, 0u, 0u, 0u};
            if (nb > 0 || kj >= 128) v = *(const u32x4_t*)(PROJ + (row0 - 128 + kj) * PROJ_W + (isv ? C_VS : C_KS) + kv * 64 + cc * 8);
            if (isv) *(LAS u32x4_t*)(lds + SW_V + (kv * 256 + kj) * 128 + ((cc ^ (((kj >> 1) & 1) << 2)) * 16)) = v;
            else *(LAS u32x4_t*)(lds + SW_K + (kv * 256 + kj) * 144 + cc * 16) = v; }
        if (tid < 128) SSQ[tid] = 0.f;
        __syncthreads();
#pragma unroll 1
        for (int p = 0; p < 4; ++p) {
            bf16x8_t qf[4];
            { const bf16_t* qp = PROJ + (row0 + 32 * p + a) * PROJ_W + C_QS + w * 64 + 8 * hi;
#pragma unroll
              for (int s = 0; s < 4; ++s) qf[s] = *(const bf16x8_t*)(qp + 16 * s); }
            const float lt = slope2 * (float)(4 * hi - a); const int al = a - 4 * hi;
#define SWA_QK(jt, accv) do { const float sj_ = lt - slope2 * (float)(128 - 32 * (jt)); \
                _Pragma("unroll") for (int r_ = 0; r_ < 16; ++r_) accv[r_] = fmaf(slope2, (float)((r_ & 3) + 8 * (r_ >> 2)), sj_); \
                const LAS unsigned char* kp_ = lds + SW_K + (kvh * 256 + 32 * (p + (jt)) + a) * 144 + 16 * hi; \
                _Pragma("unroll") for (int s_ = 0; s_ < 4; ++s_) accv = __builtin_amdgcn_mfma_f32_32x32x16_bf16(*(const LAS bf16x8_t*)(kp_ + 32 * s_), qf[s_], accv, 0, 0, 0); \
                if ((jt) == 0) { _Pragma("unroll") for (int r_ = 0; r_ < 16; ++r_) accv[r_] = ((r_ & 3) + 8 * (r_ >> 2)) > al ? accv[r_] : -INFINITY; } \
                if ((jt) == 4) { _Pragma("unroll") for (int r_ = 0; r_ < 16; ++r_) accv[r_] = ((r_ & 3) + 8 * (r_ >> 2)) <= al ? accv[r_] : -INFINITY; } } while (0)
            float mx = sink2;
#pragma unroll
            for (int jt = 0; jt < 5; ++jt) { if (nb > 0 || p + jt >= 4) { f32x16_t acc; SWA_QK(jt, acc);
#pragma unroll
                for (int r = 0; r < 16; ++r) mx = fmaxf(mx, acc[r]); } }
            mx = fmaxf(mx, __shfl_xor(mx, 32));
            float l = 0.f; f32x16_t o0 = {}, o1 = {};
            const int rq = ((lane & 15) >> 2), cb = ((lane >> 4) & 1) * 32 + (lane & 3) * 8, swz = ((rq >> 1) & 1) << 6;
#pragma unroll
            for (int jt = 0; jt < 5; ++jt) { if (nb > 0 || p + jt >= 4) { f32x16_t acc; SWA_QK(jt, acc);
#pragma unroll
                for (int r = 0; r < 16; ++r) { const float e = __builtin_amdgcn_exp2f(acc[r] - mx); acc[r] = e; l += e; }
#pragma unroll
                for (int s = 0; s < 2; ++s) { u32x4_t pw;
                    pw.x = pk2(acc[8 * s + 0], acc[8 * s + 1]); pw.y = pk2(acc[8 * s + 2], acc[8 * s + 3]); pw.z = pk2(acc[8 * s + 4], acc[8 * s + 5]); pw.w = pk2(acc[8 * s + 6], acc[8 * s + 7]);
                    const bf16x8_t pa = __builtin_bit_cast(bf16x8_t, pw);
                    const LAS unsigned char* vA = lds + SW_V + (kvh * 256 + 32 * (p + jt) + 16 * s + 4 * hi + rq) * 128;
                    const bf16x8_t v0 = cat8(lds_tr(vA + (cb ^ swz)), lds_tr(vA + 8 * 128 + (cb ^ swz)));
                    const bf16x8_t v1 = cat8(lds_tr(vA + ((cb + 64) ^ swz)), lds_tr(vA + 8 * 128 + ((cb + 64) ^ swz)));
                    o0 = __builtin_amdgcn_mfma_f32_32x32x16_bf16(pa, v0, o0, 0, 0, 0);
                    o1 = __builtin_amdgcn_mfma_f32_32x32x16_bf16(pa, v1, o1, 0, 0, 0); } } }
#undef SWA_QK
            l += __shfl_xor(l, 32); l += __builtin_amdgcn_exp2f(sink2 - mx);
            LAS float* RL = (LAS float*)(lds + SW_RL) + w * 32;
            if (hi == 0) RL[a] = 1.f / l;
            asm volatile("s_waitcnt lgkmcnt(0)" ::: "memory");
#pragma unroll
            for (int r = 0; r < 16; ++r) { const float rl = RL[(r & 3) + 8 * (r >> 2) + 4 * hi]; o0[r] *= rl; o1[r] *= rl; }
#pragma unroll
            for (int r = 0; r < 16; ++r) { float v = o0[r] * o0[r] + o1[r] * o1[r];
                v = row_sum16_f(v); v += __shfl_xor(v, 16);
                if (a == 0) atomicAdd((float*)&SSQ[32 * p + (r & 3) + 8 * (r >> 2) + 4 * hi], v); }
            __syncthreads();
            const float g0 = P.swa_norm_g[w * 64 + a], g1 = P.swa_norm_g[w * 64 + 32 + a];
#pragma unroll
            for (int r = 0; r < 16; ++r) { const int q = (r & 3) + 8 * (r >> 2) + 4 * hi; const float rs = rsqrtf(SSQ[32 * p + q] * (1.f / 512.f) + RMS_EPS);
                bf16_t* op = OMIX + (row0 + 32 * p + q) * DM + 512 + w * 64 + a;
                op[0] = (bf16_t)f2bf(o0[r] * rs * g0); op[32] = (bf16_t)f2bf(o1[r] * rs * g1); }
        }
    }
}

struct EpiProj {
    static constexpr bool PERM = true, AFTER_DRAIN = false;
    bf16_t* proj; _Float16* loga; const float* balpha;
    __device__ __forceinline__ void operator()(const pg8::f32x4 (&acc)[2][2][4][2], const pg8::Unit& u, int wr, int wc, int fr, int fq) const {
        const int row0 = u.pm * 256 + wr * 64 + fr;
        if (u.pn < 9) {
            const float sc = (u.pn == 0) ? 0.125f : (u.pn == 6 || u.pn == 7) ? 0.125f * 1.4426950408889634f : 1.f;
            const int col0 = u.pn * 256 + wc * 32 + 8 * fq;
#pragma unroll
            for (int ai = 0; ai < 2; ++ai)
#pragma unroll
                for (int m = 0; m < 4; ++m) { bf16_t* rowp = proj + (size_t)(row0 + ai * 128 + m * 16) * PROJ_W + col0;
#pragma unroll
                    for (int bj = 0; bj < 2; ++bj) { const pg8::f32x4 v0 = acc[ai][bj][m][0] * sc, v1 = acc[ai][bj][m][1] * sc;
                        u32x4_t w; w.x = pk2(v0[0], v0[1]); w.y = pk2(v0[2], v0[3]); w.z = pk2(v1[0], v1[1]); w.w = pk2(v1[2], v1[3]);
                        *(u32x4_t*)(rowp + bj * 128) = w; } }
        } else {
            const int col0 = wc * 32 + 8 * fq;
#pragma unroll
            for (int bj = 0; bj < 2; ++bj) { const f32x4_t bv0 = *(const f32x4_t*)(balpha + col0 + bj * 128), bv1 = *(const f32x4_t*)(balpha + col0 + bj * 128 + 4);
#pragma unroll
                for (int ai = 0; ai < 2; ++ai)
#pragma unroll
                    for (int m = 0; m < 4; ++m) { const f32x4_t z0 = acc[ai][bj][m][0] + bv0, z1 = acc[ai][bj][m][1] + bv1; _Float16 o[8];
#pragma unroll
                        for (int j = 0; j < 4; ++j) { o[j] = (_Float16)((fminf(z0[j], 0.f) - __logf(1.f + __expf(-fabsf(z0[j])))) * 0.0625f); o[4 + j] = (_Float16)((fminf(z1[j], 0.f) - __logf(1.f + __expf(-fabsf(z1[j])))) * 0.0625f); }
                        u32x4_t w; __builtin_memcpy(&w, o, 16);
                        *(u32x4_t*)(loga + (size_t)(row0 + ai * 128 + m * 16) * 256 + col0 + bj * 128) = w; } }
        }
    }
};
struct EpiOut {
    static constexpr bool PERM = true, AFTER_DRAIN = false;
    const float* x; const float* mod; bf16_t* x1; float* ssq;
    __device__ __forceinline__ void operator()(const pg8::f32x4 (&acc)[2][2][4][2], const pg8::Unit& u, int wr, int wc, int fr, int fq) const {
        const int row0 = u.pm * 256 + wr * 64 + fr, col0 = u.pn * 256 + wc * 32 + 8 * fq;
        const float* g1 = mod + (size_t)((u.pm * 256) / SEQ) * 6144 + 2048;
        f32x4_t ga[2], gb[2];
#pragma unroll
        for (int bj = 0; bj < 2; ++bj) { ga[bj] = *(const f32x4_t*)(g1 + col0 + bj * 128); gb[bj] = *(const f32x4_t*)(g1 + col0 + bj * 128 + 4); }
#pragma unroll
        for (int ai = 0; ai < 2; ++ai)
#pragma unroll
            for (int m = 0; m < 4; ++m) { const size_t ro = (size_t)(row0 + ai * 128 + m * 16) * DM + col0; float ss = 0.f;
#pragma unroll
                for (int bj = 0; bj < 2; ++bj) { const f32x4_t xa = *(const f32x4_t*)(x + ro + bj * 128), xb = *(const f32x4_t*)(x + ro + bj * 128 + 4);
                    const f32x4_t v0 = xa + acc[ai][bj][m][0] * ga[bj], v1 = xb + acc[ai][bj][m][1] * gb[bj];
                    ss += v0[0] * v0[0] + v0[1] * v0[1] + v0[2] * v0[2] + v0[3] * v0[3] + v1[0] * v1[0] + v1[1] * v1[1] + v1[2] * v1[2] + v1[3] * v1[3];
                    u32x4_t w; w.x = pk2(v0[0], v0[1]); w.y = pk2(v0[2], v0[3]); w.z = pk2(v1[0], v1[1]); w.w = pk2(v1[2], v1[3]);
                    *(u32x4_t*)(x1 + ro + bj * 128) = w; }
                ss += __shfl_xor(ss, 16); ss += __shfl_xor(ss, 32);
                if (fq == 0) atomicAdd(ssq + (row0 + ai * 128 + m * 16), ss); }
    }
};
struct EpiKey {
    static constexpr bool PERM = true, AFTER_DRAIN = false;
    unsigned short* skey; const float* ssq; const float* cb;
    __device__ __forceinline__ void operator()(const pg8::f32x4 (&acc)[2][2][4][2], const pg8::Unit& u, int wr, int wc, int fr, int fq) const {
        const int row0 = u.pm * 256 + wr * 64 + fr, col0 = u.pn * 256 + wc * 32 + 8 * fq;
        const float* cbb = cb + (size_t)((u.pm * 256) / SEQ) * 2048;
        float rs[2][4];
#pragma unroll
        for (int ai = 0; ai < 2; ++ai)
#pragma unroll
            for (int m = 0; m < 4; ++m) rs[ai][m] = rsqrtf(ssq[row0 + ai * 128 + m * 16] * (1.f / DM) + RMS_EPS) * 2048.f;
#pragma unroll
        for (int bj = 0; bj < 2; ++bj) { const int c = col0 + bj * 128;
            const f32x4_t cv0 = *(const f32x4_t*)(cbb + c) * 2048.f + 32768.5f, cv1 = *(const f32x4_t*)(cbb + c + 4) * 2048.f + 32768.5f;
#pragma unroll
            for (int ai = 0; ai < 2; ++ai)
#pragma unroll
                for (int m = 0; m < 4; ++m) { const f32x4_t v0 = acc[ai][bj][m][0] * rs[ai][m] + cv0, v1 = acc[ai][bj][m][1] * rs[ai][m] + cv1;
#define K16(v_) ((unsigned)__builtin_amdgcn_fmed3f((v_), 0.f, 65535.f))
                    u32x4_t w; w.x = K16(v0[0]) | (K16(v0[1]) << 16); w.y = K16(v0[2]) | (K16(v0[3]) << 16); w.z = K16(v1[0]) | (K16(v1[1]) << 16); w.w = K16(v1[2]) | (K16(v1[3]) << 16);
#undef K16
                    *(u32x4_t*)(skey + (size_t)(row0 + ai * 128 + m * 16) * 2048 + c) = w; }
        }
    }
};

__device__ __forceinline__ void transpose_write(LAS float* scr, bf16_t* WT, int row_dst0, int K, int k0, int lane) {
    const int c = lane & 7;
#pragma unroll
    for (int j = 0; j < 4; ++j) { const int n = (lane >> 3) + 8 * j; const LAS float* s = scr + (8 * c) * 33 + n;
        u32x4_t o; o.x = pk2(s[0 * 33], s[1 * 33]); o.y = pk2(s[2 * 33], s[3 * 33]); o.z = pk2(s[4 * 33], s[5 * 33]); o.w = pk2(s[6 * 33], s[7 * 33]);
        *(u32x4_t*)(WT + (size_t)(row_dst0 + n) * K + k0 + 8 * c) = o; }
}
__device__ __forceinline__ void phase_prep(const Params& P, LAS unsigned char* lds, int vb, int G) {
    const int tid0 = opaque_tid();
    unsigned char* ws = P.ws;
    bf16_t* WTIN = (bf16_t*)(ws + WS_WTIN); bf16_t* WTOUT = (bf16_t*)(ws + WS_WTOUT); float* WPF = (float*)(ws + WS_WPF);
    float* MOD = (float*)(ws + WS_MOD);
    constexpr int I_PK = 256, I_MOD = 96, I_TR = 224, NITEMS = I_PK + I_MOD + I_TR;
    for (int stage = 0; stage < 2; ++stage) {
    if ((stage ^ (vb & 1)) == 0) {
    for (int round = 0; round < 3; ++round) {
        const int it = round == 0 ? vb : round == 1 ? vb + G : (vb >= 192 ? 2 * G - 192 + vb : NITEMS);
        if (it >= NITEMS) break;
        int tid = tid0; asm volatile("" : "+v"(tid));
        const int lane = tid & 63, wave = tid >> 6;
        __syncthreads();
        if (it < I_PK) {
            const int kb = it >> 4, g = it & 15, k0 = kb * 64;
            LAS float* At = (LAS float*)lds;
            LAS float* Kt = (LAS float*)(lds + 34816);
            const float* keys = (g & 1) ? P.peer_keys_2 : P.peer_keys_1;
#pragma unroll 4
            for (int i = 0; i < 16; ++i) { const int idx = i * 512 + tid, kk = idx >> 7, d = idx & 127; At[d * 68 + kk] = P.w_peer_q[(size_t)(k0 + kk) * 2048 + g * 128 + d]; }
#pragma unroll 4
            for (int i = 0; i < 32; ++i) { const int idx = i * 512 + tid, n = idx >> 7, d = idx & 127; Kt[d * 132 + n] = keys[idx]; }
            __syncthreads();
            const int nq = tid & 31, kq = tid >> 5;
            f32x4_t acc[4];
#pragma unroll
            for (int i = 0; i < 4; ++i) acc[i] = (f32x4_t){0.f, 0.f, 0.f, 0.f};
#pragma unroll 8
            for (int d = 0; d < 128; ++d) { const f32x4_t av = *(const LAS f32x4_t*)(At + d * 68 + 4 * kq), kv = *(const LAS f32x4_t*)(Kt + d * 132 + 4 * nq);
#pragma unroll
                for (int c = 0; c < 4; ++c) acc[c] += av * kv[c]; }
#pragma unroll
            for (int c = 0; c < 4; ++c) *(f32x4_t*)(WPF + (size_t)(g * 128 + 4 * nq + c) * 1024 + k0 + 4 * kq) = acc[c];
        } else if (it < I_PK + I_MOD) {
            const int col = (it - I_PK) * 64 + lane;
            LAS float* cact = (LAS float*)lds;
            LAS float* red = (LAS float*)(lds + 16384);
#pragma unroll
            for (int i = 0; i < 8; ++i) { const int idx = i * 512 + tid; cact[idx] = silu_f(P.c[idx]); }
            __syncthreads();
            float a0 = 0.f, a1 = 0.f, a2 = 0.f, a3 = 0.f;
#pragma unroll 8
            for (int kk = 0; kk < 128; ++kk) { const int k = wave * 128 + kk; const float w = P.w_ada[(size_t)k * 6144 + col];
                a0 += cact[k] * w; a1 += cact[1024 + k] * w; a2 += cact[2048 + k] * w; a3 += cact[3072 + k] * w; }
            red[(wave * 4 + 0) * 64 + lane] = a0; red[(wave * 4 + 1) * 64 + lane] = a1; red[(wave * 4 + 2) * 64 + lane] = a2; red[(wave * 4 + 3) * 64 + lane] = a3;
            __syncthreads();
            if (tid < 256) { const int b = tid >> 6; float s = P.b_ada[col];
#pragma unroll
                for (int w = 0; w < 8; ++w) s += red[(w * 4 + b) * 64 + lane];
                MOD[b * 6144 + col] = s; }
        } else {
            const int wi = (it - I_PK - I_MOD) * 8 + wave;
            LAS float* scr = (LAS float*)(lds + wave * 8448);
            if (wi < 1152) { const int kb = wi / 72, nb = wi % 72, k0 = kb * 64, n0 = nb * 32, ns = n0 < 1024 ? n0 : n0 + 16;
#pragma unroll 8
                for (int i = 0; i < 32; ++i) { const int kk = 2 * i + (lane >> 5); scr[kk * 33 + (lane & 31)] = P.w_in[(size_t)(k0 + kk) * IN_W + ns + (lane & 31)]; }
                asm volatile("s_waitcnt lgkmcnt(0)" ::: "memory");
                transpose_write(scr, WTIN, n0, 1024, k0, lane);
            } else if (wi < 1664) { const int w2 = wi - 1152, kb = w2 / 32, nb = w2 % 32, k0 = kb * 64, n0 = nb * 32;
#pragma unroll 8
                for (int i = 0; i < 32; ++i) { const int kk = 2 * i + (lane >> 5); scr[kk * 33 + (lane & 31)] = P.w_out[(size_t)(k0 + kk) * 1024 + n0 + (lane & 31)]; }
                asm volatile("s_waitcnt lgkmcnt(0)" ::: "memory");
                transpose_write(scr, WTOUT, n0, 1024, k0, lane);
            } else { const int w2 = wi - 1664, kb = w2 / 8, nb = w2 % 8, k0 = kb * 64, n0 = nb * 32;
                for (int i = 0; i < 32; ++i) { const int kk = 2 * i + (lane >> 5); const float* wr_ = P.w_in + (size_t)(k0 + kk) * IN_W + 1024; float s = 0.f;
#pragma unroll
                    for (int r = 0; r < 16; ++r) s += wr_[r] * P.w_gla_alpha[r * 256 + n0 + (lane & 31)];
                    scr[kk * 33 + (lane & 31)] = s; }
                asm volatile("s_waitcnt lgkmcnt(0)" ::: "memory");
                transpose_write(scr, WTIN, 2304 + n0, 1024, k0, lane);
            }
            asm volatile("s_waitcnt lgkmcnt(0)" ::: "memory");
        }
    }
    } else {
    {
        int tid = tid0; asm volatile("" : "+v"(tid)); const int lane = tid & 63, wave = tid >> 6;
        unsigned* UQ = (unsigned*)(ws + WS_UBF); unsigned* VQ = (unsigned*)(ws + WS_VBF); float* USC = (float*)(ws + WS_USC); float* VSC = (float*)(ws + WS_VSC);
        const int cbu = 8 * lane, cbv = 256 * ((lane >> 1) & 1) + 16 * (lane >> 2) + 8 * (lane & 1);
        for (int r0 = (vb * NWAVES + wave) * 4; r0 < 2 * PEER_NE; r0 += G * NWAVES * 4) {
            const bool second = r0 >= PEER_NE;
            const int cb = second ? cbv : cbu; const unsigned enc = second ? 0x08080808u : 0u;
            f32x4_t v[4][4];
#pragma unroll
            for (int k = 0; k < 4; ++k) { const int r = r0 + k; const float* src = (second ? P.peer_v : P.peer_u) + (size_t)(second ? r - PEER_NE : r) * DM;
#pragma unroll
                for (int j = 0; j < 4; ++j) v[k][j] = *(const f32x4_t*)(src + 512 * (j >> 1) + cb + 4 * (j & 1)); }
#pragma unroll
            for (int k = 0; k < 4; ++k) { const int e = second ? r0 + k - PEER_NE : r0 + k; float mx = 0.f, sq = 0.f;
#pragma unroll
                for (int j = 0; j < 4; ++j)
#pragma unroll
                    for (int q = 0; q < 4; ++q) { mx = fmaxf(mx, fabsf(v[k][j][q])); sq += v[k][j][q] * v[k][j][q]; }
                mx = row_max16_f(mx); mx = fmaxf(mx, __shfl_xor(mx, 16)); mx = fmaxf(mx, __shfl_xor(mx, 32)); sq = wave_sum(sq);
                const float s1 = fmaxf(mx, 1e-30f) * (1.f / 7.f), s2 = fminf(fmaxf(sqrtf(sq * (1.f / 1024.f)) * 0.36f, 1e-30f), s1), i1 = 1.f / s1, i2 = 1.f / s2;
                float e1 = 0.f, e2 = 0.f;
#pragma unroll
                for (int j = 0; j < 4; ++j) { const float x = v[k][j][0];
                        const float d1 = x - __builtin_amdgcn_fmed3f(rintf(x * i1), -7.f, 7.f) * s1, d2 = x - __builtin_amdgcn_fmed3f(rintf(x * i2), -7.f, 7.f) * s2; e1 += d1 * d1; e2 += d2 * d2; }
                e1 = wave_sum(e1); e2 = wave_sum(e2);
                const float sc = e2 < e1 ? s2 : s1, inv = 1.f / sc;
                unsigned* dst = (second ? VQ : UQ) + (size_t)e * 128;
#pragma unroll
                for (int jj = 0; jj < 2; ++jj) { unsigned w = 0;
#pragma unroll
                    for (int q = 0; q < 8; ++q) { const int bq = (int)__builtin_amdgcn_fmed3f(rintf(v[k][2 * jj + (q >> 2)][q & 3] * inv), -7.f, 7.f); w |= ((unsigned)bq & 15u) << (4 * q); }
                    dst[lane + 64 * jj] = w ^ enc; }
                if (lane == 0) (second ? VSC : USC)[e] = sc; }
        }
    }
    }
    }
    { float* SSQ2 = (float*)(ws + WS_SSQ2); for (int i = vb * NTHREADS + tid0; i < NT; i += G * NTHREADS) SSQ2[i] = 0.f; }
}

__device__ __forceinline__ void phase_normmod(const float* src, const bf16_t* add, const float* gain, const float* mod, int shift_off, int scale_off, bf16_t* dst, int vb, int G) {
    const int tid = opaque_tid(), lane = tid & 63, wave = tid >> 6;
    for (int row = vb * NWAVES + wave; row < NT; row += G * NWAVES) {
        const float* xr = src + (size_t)row * DM; const float* mb = mod + (size_t)(row / SEQ) * 6144;
        f32x4_t v[4]; float s = 0.f;
#pragma unroll
        for (int j = 0; j < 4; ++j) { v[j] = *(const f32x4_t*)(xr + 4 * lane + 256 * j);
            if (add) { const u32x2_t yv = *(const u32x2_t*)(add + (size_t)row * DM + 4 * lane + 256 * j); v[j][0] += bflo(yv.x); v[j][1] += bfhi(yv.x); v[j][2] += bflo(yv.y); v[j][3] += bfhi(yv.y); }
            s += v[j][0] * v[j][0] + v[j][1] * v[j][1] + v[j][2] * v[j][2] + v[j][3] * v[j][3]; }
        const float rstd = rsqrtf(wave_sum(s) * (1.f / DM) + RMS_EPS);
#pragma unroll
        for (int j = 0; j < 4; ++j) { const int c = 4 * lane + 256 * j;
            const f32x4_t g = *(const f32x4_t*)(gain + c), sh = *(const f32x4_t*)(mb + shift_off + c), sc = *(const f32x4_t*)(mb + scale_off + c);
            const f32x4_t h = (v[j] * rstd) * g * (sc + 1.f) + sh;
            u32x2_t o; o.x = pk2(h[0], h[1]); o.y = pk2(h[2], h[3]);
            *(u32x2_t*)(dst + (size_t)row * DM + c) = o; }
    }
}

__device__ __forceinline__ void phase_wpk_batch(const Params& P, int vb, int G) {
    const int tid = opaque_tid(), lane = tid & 63, wave = tid >> 6;
    const float* WPF = (const float*)(P.ws + WS_WPF); const float* MOD = (const float*)(P.ws + WS_MOD); bf16_t* WB = (bf16_t*)(P.ws + WS_WTPKB); float* CB = (float*)(P.ws + WS_CB);
    for (int it = vb * NWAVES + wave; it < NB * 2048; it += G * NWAVES) {
        const int b = it >> 11, n = it & 2047; const float* mb = MOD + (size_t)b * 6144; float dot = 0.f;
#pragma unroll
        for (int j = 0; j < 4; ++j) { const int c = 4 * lane + 256 * j;
            const f32x4_t w = *(const f32x4_t*)(WPF + (size_t)n * 1024 + c), gn = *(const f32x4_t*)(P.norm2_g + c), sc = *(const f32x4_t*)(mb + 4096 + c), sh = *(const f32x4_t*)(mb + 3072 + c);
            const f32x4_t o = w * gn * (sc + 1.f); dot += w[0] * sh[0] + w[1] * sh[1] + w[2] * sh[2] + w[3] * sh[3];
            u32x2_t pk; pk.x = pk2(o[0], o[1]); pk.y = pk2(o[2], o[3]); *(u32x2_t*)(WB + ((size_t)b * 2048 + n) * 1024 + c) = pk; }
        dot = wave_sum(dot);
        if (lane == 0) CB[b * 2048 + n] = dot;
    }
}


__device__ __forceinline__ void route_quad(const unsigned short* SKEY, int t0, LAS unsigned* stage, LAS unsigned char* idxb, LAS unsigned* raw, int tokbase, int lane) {
    unsigned L[16];
#pragma unroll
    for (int j = 0; j < 16; ++j) L[j] = 0u;
    for (int p = 0; p < 2; ++p) {
        asm volatile("s_waitcnt lgkmcnt(0)" ::: "memory");
#pragma unroll
        for (int i = 0; i < 8; ++i) { const int seg = i * 8 + (lane >> 3), ch = lane & 7;
            const u32x4_t v = __builtin_nontemporal_load((const u32x4_t*)(SKEY + (size_t)(t0 + (seg >> 4)) * 2048 + (seg & 15) * 128 + p * 64 + ch * 8));
            *(LAS u32x4_t*)(stage + seg * 36 + ch * 4) = v; }
        asm volatile("s_waitcnt lgkmcnt(0)" ::: "memory");
#pragma unroll
        for (int q4 = 0; q4 < 4; ++q4) { unsigned N[16];
#pragma unroll
            for (int cch = 0; cch < 2; ++cch) { const u32x4_t v = *(const LAS u32x4_t*)(stage + lane * 36 + (q4 * 2 + cch) * 4);
#pragma unroll
                for (int d = 0; d < 4; ++d) { const unsigned ib = 127u - (unsigned)(p * 64 + q4 * 16 + cch * 8 + 2 * d);
                    N[cch * 8 + 2 * d] = ((v[d] & 0xffffu) << 7) | ib; N[cch * 8 + 2 * d + 1] = ((v[d] >> 16) << 7) | (ib - 1u); } }
            sort16_desc(N); merge_top16(L, N); }
    }
#pragma unroll
    for (int j = 0; j < 4; ++j) { unsigned w = 0;
#pragma unroll
        for (int q = 0; q < 4; ++q) w |= (127u - (L[4 * j + q] & 127u)) << (8 * q);
        *(LAS unsigned*)(idxb + lane * 16 + 4 * j) = w; }
    float v1[16], v2[16];
    { const bool odd = lane & 1;
#pragma unroll
      for (int j = 0; j < 16; ++j) { const float mine = (float)(L[j] >> 7) * (1.f / 2048.f) - 16.f; const float oth = dpp_swap1_f(mine); v1[j] = odd ? oth : mine; v2[j] = odd ? mine : oth; } }
#define CKEY(i, j) ((f2key(v1[i] + v2[j]) & ~255u) | (255u - (unsigned)((i) * 16 + (j))))
    unsigned C[16];
#pragma unroll
    for (int j = 0; j < 16; ++j) C[j] = CKEY(0, j);
    { unsigned N[16] = {CKEY(1, 0), CKEY(1, 1), CKEY(1, 2), CKEY(1, 3), CKEY(1, 4), CKEY(1, 5), CKEY(1, 6), CKEY(1, 7), CKEY(2, 0), CKEY(2, 1), CKEY(2, 2), CKEY(2, 3), CKEY(2, 4), CKEY(4, 0), CKEY(4, 1), CKEY(4, 2)};
      sort16_desc(N); merge_top16(C, N); }
    { unsigned N[16] = {CKEY(3, 0), CKEY(3, 1), CKEY(3, 2), CKEY(3, 3), CKEY(5, 0), CKEY(5, 1), CKEY(6, 0), CKEY(6, 1), CKEY(7, 0), CKEY(7, 1), CKEY(8, 0), CKEY(9, 0), CKEY(10, 0), CKEY(11, 0), CKEY(12, 0), CKEY(13, 0)};
      sort16_desc(N); merge_top16(C, N); }
    insert16(C, CKEY(14, 0)); insert16(C, CKEY(15, 0));
#undef CKEY
    asm volatile("s_waitcnt lgkmcnt(0)" ::: "memory");
    const float mx = key2f(C[0] & ~255u); float e[16], se = 0.f;
#pragma unroll
    for (int j = 0; j < 16; ++j) { e[j] = __expf(key2f(C[j] & ~255u) - mx); se += e[j]; }
    const float rs = 32768.f / se;
    if (!(lane & 1)) { const int tok = lane >> 4, head = (lane & 15) >> 1;
#pragma unroll
        for (int j = 0; j < 16; ++j) { const unsigned code = 255u - (C[j] & 255u); const unsigned e1 = idxb[lane * 16 + (code >> 4)], e2 = idxb[(lane + 1) * 16 + (code & 15u)];
            unsigned g15 = (unsigned)(e[j] * rs); g15 = g15 > 32767u ? 32767u : g15;
            raw[tok * 128 + head * 16 + j] = (e1 * 128u + e2) | ((unsigned)(tokbase + tok) << 14) | (g15 << 17); } }
    asm volatile("s_waitcnt lgkmcnt(0)" ::: "memory");
}

__device__ __forceinline__ float gelu_erf(float v) {
    const float av = fabsf(v), t = __builtin_amdgcn_rcpf(av * 0.2316418882f + 1.0f);
    float q = t * 0.5307027145f + (-0.7265760135f); q = q * t + 0.7107068705f; q = q * t + (-0.142248368f); q = q * t + 0.127414796f; q = q * t;
    const float m = v * (q * __builtin_amdgcn_exp2f((v * v) * (-0.72134752044f)));
    return v < 0.f ? m : v - m;
}
__device__ __forceinline__ int dot16_i8(const u32x4_t b, const unsigned h0, const unsigned h1, const unsigned h2, const unsigned h3, int s) {
    s = __builtin_amdgcn_sdot4((int)b.x, (int)h0, s, false); s = __builtin_amdgcn_sdot4((int)b.y, (int)h1, s, false);
    s = __builtin_amdgcn_sdot4((int)b.z, (int)h2, s, false); return __builtin_amdgcn_sdot4((int)b.w, (int)h3, s, false);
}
constexpr int P4_SLOT = 10304  , P4_SLOTS = 0, P4_RA = 8 * P4_SLOT, P4_RAW = 9216, P4_IDX = 13312, P4_CNT = 14336, P4_RSZ = 15360, P4_TBL = P4_RA + 4 * P4_RSZ, P4_FLG = P4_TBL + 16384;
static_assert(P4_FLG + 64 <= MISC_OFF, "peer (specialised) LDS map");

template <bool WRITE, int MASK> __device__ __forceinline__ void gather_sweep(const Params& P, LAS unsigned* MK, LAS float* MS, LAS float* MV, const unsigned (&hq)[16], float sh, size_t row, int li,
                                                                   const LAS float* GT2L, const LAS float* FGL) {
    const unsigned* UQ = (const unsigned*)(P.ws + WS_UBF)  ; const unsigned* VQ = (const unsigned*)(P.ws + WS_VBF); const bf16_t* X1 = (const bf16_t*)(P.ws + WS_X1);
    const unsigned lo = (unsigned)li * 4u; float wmx = 0.f;
#define P3_LOADV(buf, eidv, s) do { _Pragma("unroll") for (int u_ = 0; u_ < 4; ++u_) { eidv[u_] = MK[(s) + u_]; const unsigned* rp_ = VQ + (size_t)eidv[u_] * 128 + lo; \
        buf[u_][0] = *(const u32x4_t*)rp_; buf[u_][1] = *(const u32x4_t*)(rp_ + 64); } } while (0)
    u32x4_t vA[4][2], vB[4][2], vC[4][2]; unsigned fA[4], fB[4], fC[4];
    if (MASK & 2) {
        u32x4_t bA[4][2], bB[4][2], bC[4][2], bD[4][2]; unsigned eA[4], eB[4], eC[4], eD[4];
#define P3_LOADU(buf, eidv, s) do { _Pragma("unroll") for (int u_ = 0; u_ < 4; ++u_) { eidv[u_] = MK[(s) + u_]; const unsigned* rp_ = UQ + (size_t)eidv[u_] * 128 + lo; \
        buf[u_][0] = *(const u32x4_t*)rp_; buf[u_][1] = *(const u32x4_t*)(rp_ + 64); } } while (0)
#define P3_DPPI(v_, ctl_) __builtin_amdgcn_mov_dpp((v_), (ctl_), 0xf, 0xf, false)
#define P3_UDOT(buf, k0_) do { _Pragma("unroll") for (int u_ = 0; u_ < 4; ++u_) { int dh_ = 0, dl_ = 0; \
                _Pragma("unroll") for (int j_ = 0; j_ < 2; ++j_) _Pragma("unroll") for (int q_ = 0; q_ < 4; ++q_) { \
                    dh_ = __builtin_amdgcn_sdot8((int)buf[u_][j_][q_], (int)hq[4 * j_ + q_], dh_, false); dl_ = __builtin_amdgcn_sdot8((int)buf[u_][j_][q_], (int)hq[8 + 4 * j_ + q_], dl_, false); } \
                dd[(k0_) + u_] = dh_ * 16 + dl_; } } while (0)
#define P3_UFIN(s) do { int e_[8], f_[4], g_[2]; \
            _Pragma("unroll") for (int k_ = 0; k_ < 8; ++k_) { const int sd_ = h8 ? dd[k_] : dd[8 + k_]; e_[k_] = (h8 ? dd[8 + k_] : dd[k_]) + P3_DPPI(sd_, 0x140); } \
            _Pragma("unroll") for (int k_ = 0; k_ < 4; ++k_) { const int sd_ = h4 ? e_[k_] : e_[4 + k_]; f_[k_] = (h4 ? e_[4 + k_] : e_[k_]) + P3_DPPI(sd_, 0x141); } \
            _Pragma("unroll") for (int k_ = 0; k_ < 2; ++k_) { const int sd_ = h2 ? f_[k_] : f_[2 + k_]; g_[k_] = (h2 ? f_[2 + k_] : f_[k_]) + P3_DPPI(sd_, 0x1B); } \
            const int sd1_ = h1 ? g_[0] : g_[1]; const int m_ = (h1 ? g_[1] : g_[0]) + P3_DPPI(sd1_, 0xB1); \
            const int si_ = (s) + li; \
            const float a_ = MS[si_] * sh * (float)m_; const float w_ = MV[si_] * gelu_erf(a_); \
            MV[si_] = w_; wmx = fmaxf(wmx, fabsf(w_)); } while (0)
        const bool h8 = li & 8, h4 = li & 4, h2 = li & 2, h1 = li & 1; int dd[16];
        P3_LOADU(bA, eA, 0); P3_LOADU(bB, eB, 4); P3_LOADU(bC, eC, 8);
#pragma unroll 1
        for (int s = 0; s < 112; s += 16) {
            P3_LOADU(bD, eD, s + 12); P3_UDOT(bA, 0);
            P3_LOADU(bA, eA, s + 16); P3_UDOT(bB, 4);
            P3_LOADU(bB, eB, s + 20); P3_UDOT(bC, 8);
            P3_LOADU(bC, eC, s + 24); P3_UDOT(bD, 12);
            P3_UFIN(s);
        }
        P3_LOADU(bD, eD, 124); P3_UDOT(bA, 0);
        P3_LOADV(vA, fA, 0);   P3_UDOT(bB, 4);
        P3_LOADV(vB, fB, 4);   P3_UDOT(bC, 8);
        P3_UDOT(bD, 12);
        P3_UFIN(112);
#undef P3_UDOT
#undef P3_UFIN
#undef P3_LOADU
    }
    asm volatile("s_waitcnt lgkmcnt(0)" ::: "memory");
    wmx = row_max16_f(wmx);
    u32x2_t xw[16];
#pragma unroll
    for (int j = 0; j < 4; ++j)
#pragma unroll
        for (int q = 0; q < 4; ++q) xw[4 * j + q] = *(const u32x2_t*)(X1 + row * DM + j * 256 + li * 16 + q * 4);
    const float wscale = fmaxf(wmx, 1e-30f) * (1.f / 127.f), winv = 1.f / wscale;
    LAS unsigned* WQ = (LAS unsigned*)MS; int wsum = 0;
    {
        const f32x4_t wa = *(const LAS f32x4_t*)(MV + 8 * li), wb = *(const LAS f32x4_t*)(MV + 8 * li + 4);
        const int a0 = (int)rintf(wa[0] * winv), a1 = (int)rintf(wa[1] * winv), a2 = (int)rintf(wa[2] * winv), a3 = (int)rintf(wa[3] * winv);
        const int b0 = (int)rintf(wb[0] * winv), b1 = (int)rintf(wb[1] * winv), b2 = (int)rintf(wb[2] * winv), b3 = (int)rintf(wb[3] * winv);
        wsum = row_sum16_i(a0 + a1 + a2 + a3 + b0 + b1 + b2 + b3);
        u32x2_t pk; pk.x = (unsigned)(a0 & 255) | ((unsigned)(a1 & 255) << 8) | ((unsigned)(a2 & 255) << 16) | ((unsigned)a3 << 24);
        pk.y = (unsigned)(b0 & 255) | ((unsigned)(b1 & 255) << 8) | ((unsigned)(b2 & 255) << 16) | ((unsigned)b3 << 24);
        *(LAS u32x2_t*)(WQ + 2 * li) = pk;
    }
    int iacc[64];
#pragma unroll
    for (int q = 0; q < 64; ++q) iacc[q] = 0;
    if (MASK & 4) {
#define P3_VCOMP(buf, s) do { const int w4_ = (int)WQ[(s) >> 2]; \
            _Pragma("unroll") for (int j_ = 0; j_ < 2; ++j_) _Pragma("unroll") for (int q_ = 0; q_ < 4; ++q_) { const unsigned ra_ = buf[0][j_][q_], rb_ = buf[1][j_][q_], rc_ = buf[2][j_][q_], rd_ = buf[3][j_][q_]; \
                const unsigned ab0_ = __builtin_amdgcn_perm(rb_, ra_, 0x05010400u), ab1_ = __builtin_amdgcn_perm(rb_, ra_, 0x07030602u); \
                const unsigned cd0_ = __builtin_amdgcn_perm(rd_, rc_, 0x05010400u), cd1_ = __builtin_amdgcn_perm(rd_, rc_, 0x07030602u); \
                const int u0_ = (int)__builtin_amdgcn_perm(cd0_, ab0_, 0x05040100u), u1_ = (int)__builtin_amdgcn_perm(cd0_, ab0_, 0x07060302u); \
                const int u2_ = (int)__builtin_amdgcn_perm(cd1_, ab1_, 0x05040100u), u3_ = (int)__builtin_amdgcn_perm(cd1_, ab1_, 0x07060302u); \
                const int ix_ = 16 * (2 * j_ + (q_ >> 1)) + 8 * (q_ & 1); \
                iacc[ix_] = __builtin_amdgcn_sdot4(u0_, w4_, iacc[ix_], false); iacc[ix_ + 1] = __builtin_amdgcn_sdot4(u0_ & (int)0xF0F0F0F0u, w4_, iacc[ix_ + 1], false); \
                iacc[ix_ + 2] = __builtin_amdgcn_sdot4(u1_, w4_, iacc[ix_ + 2], false); iacc[ix_ + 3] = __builtin_amdgcn_sdot4(u1_ & (int)0xF0F0F0F0u, w4_, iacc[ix_ + 3], false); \
                iacc[ix_ + 4] = __builtin_amdgcn_sdot4(u2_, w4_, iacc[ix_ + 4], false); iacc[ix_ + 5] = __builtin_amdgcn_sdot4(u2_ & (int)0xF0F0F0F0u, w4_, iacc[ix_ + 5], false); \
                iacc[ix_ + 6] = __builtin_amdgcn_sdot4(u3_, w4_, iacc[ix_ + 6], false); iacc[ix_ + 7] = __builtin_amdgcn_sdot4(u3_ & (int)0xF0F0F0F0u, w4_, iacc[ix_ + 7], false); } } while (0)
        if (!(MASK & 2)) { P3_LOADV(vA, fA, 0); P3_LOADV(vB, fB, 4); }
#pragma unroll 1
        for (int s = 0; s < 120; s += 12) {
            P3_LOADV(vC, fC, s + 8);  P3_VCOMP(vA, s);
            P3_LOADV(vA, fA, s + 12); P3_VCOMP(vB, s + 4);
            P3_LOADV(vB, fB, s + 16); P3_VCOMP(vC, s + 8);
        }
        P3_VCOMP(vA, 120); P3_VCOMP(vB, 124);
#undef P3_VCOMP
    }
#undef P3_LOADV
    {
        const int w8 = 8 * wsum;
#pragma unroll
        for (int q = 0; q < 64; q += 2) { const int o_ = iacc[q + 1]; iacc[q] = iacc[q] - o_ - w8; iacc[q + 1] = o_ >> 4; }
    }
    {
        float* xr = P.out + row * DM;
        float ssq = 0.f; float acc[64];
#pragma unroll
        for (int j = 0; j < 4; ++j)
#pragma unroll
            for (int q = 0; q < 4; ++q) { const int c = j * 256 + li * 16 + q * 4; const f32x4_t gv = *(const LAS f32x4_t*)(GT2L + c);
                const u32x2_t xw2 = xw[4 * j + q]; const float xv[4] = {bflo(xw2.x), bfhi(xw2.x), bflo(xw2.y), bfhi(xw2.y)};
#pragma unroll
                for (int rr = 0; rr < 4; ++rr) { const float v = xv[rr] + gv[rr] * ((float)iacc[16 * j + 4 * q + rr] * wscale); acc[16 * j + 4 * q + rr] = v; ssq += v * v; } }
        ssq = row_sum16_f(ssq);
        const float rstd = rsqrtf(ssq * (1.f / DM) + RMS_EPS);
#pragma unroll
        for (int j = 0; j < 4; ++j)
#pragma unroll
            for (int q = 0; q < 4; ++q) { const int c = j * 256 + li * 16 + q * 4; const f32x4_t fg = *(const LAS f32x4_t*)(FGL + c); f32x4_t o;
#pragma unroll
                for (int rr = 0; rr < 4; ++rr) o[rr] = acc[16 * j + 4 * q + rr] * rstd * fg[rr];
                if (WRITE) *(f32x4_t*)(xr + c) = o; else asm volatile("" :: "v"(o)); }
    }
}

template <bool WRITE, int MASK = 7> __device__ __forceinline__ void phase_peer3(const Params& P, LAS unsigned char* lds, int vb, int G) {
    const int tid = opaque_tid(), lane0 = tid & 63, wave = __builtin_amdgcn_readfirstlane(tid >> 6);
    const unsigned short* SKEY = (const unsigned short*)(P.ws + WS_SKEY); const bf16_t* X1 = (const bf16_t*)(P.ws + WS_X1);
    const float* USC = (const float*)(P.ws + WS_USC); const float* VSC = (const float*)(P.ws + WS_VSC);
    const float* MOD = (const float*)(P.ws + WS_MOD);
    const int blk = vb;
    LAS float* G2L = (LAS float*)(lds + P4_TBL); LAS float* B2L = G2L + 1024; LAS float* GT2L = G2L + 2048; LAS float* FGL = G2L + 3072;
    volatile LAS unsigned* FLG = (volatile LAS unsigned*)(lds + P4_FLG);
    { const float* mb = MOD + (size_t)((blk * 128) / SEQ) * 6144;
      for (int c = tid; c < 1024; c += NTHREADS) { G2L[c] = P.norm2_g[c] * (1.f + mb[4096 + c]); B2L[c] = mb[3072 + c]; GT2L[c] = mb[5120 + c]; FGL[c] = P.final_g[c]; }
      if (tid < 16) FLG[tid] = 0u; }
    __syncthreads();
    if (wave >= 4) {
        const int r = wave - 4;
        LAS unsigned char* ra = lds + P4_RA + r * P4_RSZ;
        LAS unsigned* RAW = (LAS unsigned*)(ra + P4_RAW); LAS unsigned char* IDX = ra + P4_IDX; LAS unsigned* CNT = (LAS unsigned*)(ra + P4_CNT);
        unsigned* QC = (unsigned*)(P.ws + WS_CTL) + 8192 + 64 * (blk >> 6);
#pragma unroll 1
        for (int sw = 0; sw < 2048; ++sw) {
            int lane = lane0; asm volatile("" : "+v"(lane));
            const int g = lane >> 4, li = lane & 15;
            unsigned qn = 0; if (lane == 0) qn = xb_add(QC, 1u);
            qn = (unsigned)__builtin_amdgcn_readfirstlane((int)qn);
            if (qn >= 2048u) {
                if (sw >= 2) { unsigned spins = 0; while (FLG[4 + r] < (unsigned)(sw - 1) && ++spins < (1u << 22)) __builtin_amdgcn_s_sleep(8); }
                if (lane == 0) { ((volatile LAS int*)(lds + P4_SLOTS + (r * 2 + (sw & 1)) * P4_SLOT + 10240))[8] = -1; }
                asm volatile("s_waitcnt lgkmcnt(0)" ::: "memory");
                if (lane == 0) FLG[r] = (unsigned)(sw + 1);
                asm volatile("s_waitcnt lgkmcnt(0)" ::: "memory");
                break;
            }
            const int tw0 = (blk >> 6) * SEQ + (int)qn * 4;
            route_quad(SKEY, tw0, (LAS unsigned*)ra, IDX, RAW, 0, lane);
#pragma unroll
            for (int t = 0; t < 4; ++t) CNT[t * 64 + lane] = 0u;
            asm volatile("s_waitcnt lgkmcnt(0)" ::: "memory");
#pragma unroll
            for (int i = 0; i < 8; ++i) { const unsigned e = RAW[i * 64 + lane]; __hip_atomic_fetch_add(CNT + (i >> 1) * 64 + ((e & 0x3fffu) >> 8), 1u, __ATOMIC_RELAXED, __HIP_MEMORY_SCOPE_WORKGROUP); }
            asm volatile("s_waitcnt lgkmcnt(0)" ::: "memory");
#pragma unroll
            for (int t = 0; t < 4; ++t) { const unsigned c = CNT[t * 64 + lane]; const unsigned inc = wave_incl_scan_u32(c); CNT[t * 64 + lane] = inc - c + t * 128; }
            asm volatile("s_waitcnt lgkmcnt(0)" ::: "memory");
            if (sw >= 2) { unsigned spins = 0; while (FLG[4 + r] < (unsigned)(sw - 1) && ++spins < (1u << 22)) __builtin_amdgcn_s_sleep(8); }
            LAS unsigned char* sl = lds + P4_SLOTS + (r * 2 + (sw & 1)) * P4_SLOT;
            LAS unsigned* KEYS = (LAS unsigned*)sl; LAS float* SU = (LAS float*)(sl + 2048); LAS float* VALS = (LAS float*)(sl + 4096);
#pragma unroll
            for (int i = 0; i < 8; ++i) { const unsigned e = RAW[i * 64 + lane]; const unsigned pos = __hip_atomic_fetch_add(CNT + (i >> 1) * 64 + ((e & 0x3fffu) >> 8), 1u, __ATOMIC_RELAXED, __HIP_MEMORY_SCOPE_WORKGROUP);
                const unsigned eid = e & 0x3fffu; KEYS[pos] = eid; VALS[pos] = (float)(e >> 17) * (1.f / 32768.f) * VSC[eid]; SU[pos] = USC[eid]; }
            const size_t row = (size_t)(tw0 + g);
            unsigned hq[16]; float sh;
            {
              unsigned xw[32];
              const float rstd2 = rsqrtf(((const float*)(P.ws + WS_SSQ2))[row] * (1.f / DM) + RMS_EPS);
#pragma unroll
              for (int j = 0; j < 2; ++j)
#pragma unroll
                  for (int i = 0; i < 4; ++i) { const u32x4_t a = *(const u32x4_t*)(X1 + row * DM + j * 512 + li * 32 + i * 8);
#pragma unroll
                      for (int q = 0; q < 4; ++q) xw[16 * j + 4 * i + q] = a[q]; }
#define P3_H4(d_, h_) do { const int c_ = ((d_) >> 3) * 512 + li * 32 + ((d_) & 7) * 4; const f32x4_t gn_ = *(const LAS f32x4_t*)(G2L + c_), sf_ = *(const LAS f32x4_t*)(B2L + c_); \
                  const unsigned w0_ = xw[2 * (d_)], w1_ = xw[2 * (d_) + 1]; \
                  h_[0] = bflo(w0_) * rstd2 * gn_[0] + sf_[0]; h_[1] = bfhi(w0_) * rstd2 * gn_[1] + sf_[1]; h_[2] = bflo(w1_) * rstd2 * gn_[2] + sf_[2]; h_[3] = bfhi(w1_) * rstd2 * gn_[3] + sf_[3]; } while (0)
              float mx = 0.f;
#pragma unroll
              for (int d = 0; d < 16; ++d) { float h4[4]; P3_H4(d, h4); mx = fmaxf(mx, fmaxf(fmaxf(fabsf(h4[0]), fabsf(h4[1])), fmaxf(fabsf(h4[2]), fabsf(h4[3])))); }
              mx = row_max16_f(mx);
              sh = fmaxf(mx, 1e-30f) * (1.f / 119.f); const float inv = 1.f / sh;
#pragma unroll
              for (int D = 0; D < 8; ++D) { unsigned wh = 0, wl = 0;
#pragma unroll
                  for (int hf_ = 0; hf_ < 2; ++hf_) { float h4[4]; P3_H4(2 * D + hf_, h4);
#pragma unroll
                      for (int q = 0; q < 4; ++q) { const unsigned t = (unsigned)((int)rintf(h4[q] * inv) + 8);
                          wl |= (t & 15u) << (4 * (4 * hf_ + q)); wh |= ((t >> 4) & 15u) << (4 * (4 * hf_ + q)); } }
                  hq[D] = wh; hq[8 + D] = wl ^ 0x88888888u; }
#undef P3_H4
            }
#pragma unroll
            for (int d4 = 0; d4 < 4; ++d4) { u32x4_t hv; hv.x = hq[4 * d4]; hv.y = hq[4 * d4 + 1]; hv.z = hq[4 * d4 + 2]; hv.w = hq[4 * d4 + 3]; *(LAS u32x4_t*)(sl + 6144 + lane * 64 + d4 * 16) = hv; }
            if (li == 0) ((LAS float*)(sl + 10240))[g] = sh;
            if (lane == 0) ((volatile LAS int*)(sl + 10240))[8] = tw0;
            asm volatile("s_waitcnt vmcnt(0) lgkmcnt(0)" ::: "memory");
            if (lane == 0) FLG[r] = (unsigned)(sw + 1);
            asm volatile("s_waitcnt lgkmcnt(0)" ::: "memory");
        }
    } else {
        const int r = wave;
        __builtin_amdgcn_s_setprio(3);
#pragma unroll 1
        for (int sw = 0; sw < 2049; ++sw) {
            int lane = lane0; asm volatile("" : "+v"(lane));
            const int g = lane >> 4, li = lane & 15;
            { unsigned spins = 0; while (FLG[r] < (unsigned)(sw + 1) && ++spins < (1u << 22)) __builtin_amdgcn_s_sleep(8); }
            asm volatile("s_waitcnt lgkmcnt(0)" ::: "memory");
            LAS unsigned char* sl = lds + P4_SLOTS + (r * 2 + (sw & 1)) * P4_SLOT;
            const int tw0 = __builtin_amdgcn_readfirstlane(((volatile LAS int*)(sl + 10240))[8]);
            if (tw0 < 0) break;
            const size_t row = (size_t)(tw0 + g);
            unsigned hq[16]; const float sh = ((LAS float*)(sl + 10240))[g];
#pragma unroll
            for (int d4 = 0; d4 < 4; ++d4) { const u32x4_t hv = *(const LAS u32x4_t*)(sl + 6144 + lane * 64 + d4 * 16); hq[4 * d4] = hv.x; hq[4 * d4 + 1] = hv.y; hq[4 * d4 + 2] = hv.z; hq[4 * d4 + 3] = hv.w; }
            gather_sweep<WRITE, MASK>(P, (LAS unsigned*)sl + g * 128, (LAS float*)(sl + 2048) + g * 128, (LAS float*)(sl + 4096) + g * 128, hq, sh, row, li, GT2L, FGL);
            asm volatile("s_waitcnt lgkmcnt(0)" ::: "memory");
            if (lane == 0) FLG[4 + r] = (unsigned)(sw + 1);
        }
    }
    __builtin_amdgcn_s_setprio(0);
    __syncthreads();
}
struct Args { Params p; };

template <class Epi> __device__ __forceinline__ void run_gemm(LAS unsigned char* lds, const bf16_t* A, const bf16_t* Bt, int N, const Epi& E, int bsel_tiles = 0) {
    pg8::Gemm g{A, Bt, NT, N, DM, bsel_tiles, SEQ / 256};
    pg8::StaticOrder S; S.init(NT, N, (int)gridDim.x, (int)blockIdx.x);
    pg8::gemm_phase<Epi, pg8::StaticOrder, true, true>(lds, g, S, E);
}

constexpr int CW_BAR = 1024;
__device__ __forceinline__ const Params* opaque_params() {
    auto k = __builtin_amdgcn_kernarg_segment_ptr();
    asm volatile("" : "+s"(k));
    return (const Params*)k;
}
__global__ void __launch_bounds__(NTHREADS, 2) mega_kernel(Args a) {
    extern __shared__ __attribute__((aligned(16))) unsigned char smem[];
    LAS unsigned char* lds = (LAS unsigned char*)smem;
    const int vb = blockIdx.x, G = gridDim.x;
    if (threadIdx.x < 128) ((LAS unsigned*)(lds + MISC_OFF))[threadIdx.x] = 0u;
    __syncthreads();
    XcdBarrier bar = xcd_barrier_post((unsigned*)(a.p.ws + WS_CTL) + CW_BAR, (volatile LAS unsigned*)(lds + MISC_OFF) + 8);
#define GRID_BAR() xcd_barrier(bar)
#define LOADP() const Params P = *opaque_params(); unsigned char* ws = P.ws; const float* MOD = (const float*)(ws + WS_MOD); (void)MOD
    { LOADP(); phase_prep(P, lds, vb, G); }
    GRID_BAR();
    { LOADP(); phase_normmod(P.x, nullptr, P.norm1_g, MOD, 0, 1024, (bf16_t*)(ws + WS_H), vb, G); phase_wpk_batch(P, vb, G); }
    GRID_BAR();
    { LOADP(); EpiProj E{(bf16_t*)(ws + WS_PROJ), (_Float16*)(ws + WS_LOGA), P.b_gla_alpha}; run_gemm(lds, (const bf16_t*)(ws + WS_H), (const bf16_t*)(ws + WS_WTIN), NPAD, E); }
    GRID_BAR();
    { LOADP(); if (vb & 1) { phase_swa(P, lds, vb, G); phase_gla<false>(P, lds, vb, G); } else { phase_gla<false>(P, lds, vb, G); phase_swa(P, lds, vb, G); } }
    GRID_BAR();
    { LOADP(); phase_gla<true>(P, lds, vb, G); }
    GRID_BAR();
    { LOADP(); EpiOut E{P.x, MOD, (bf16_t*)(ws + WS_X1), (float*)(ws + WS_SSQ2)}; run_gemm(lds, (const bf16_t*)(ws + WS_OMIX), (const bf16_t*)(ws + WS_WTOUT), DM, E); }
    GRID_BAR();
    { LOADP(); EpiKey E{(unsigned short*)(ws + WS_SKEY), (const float*)(ws + WS_SSQ2), (const float*)(ws + WS_CB)}; run_gemm(lds, (const bf16_t*)(ws + WS_X1), (const bf16_t*)(ws + WS_WTPKB), 2048, E, 8); }
    GRID_BAR();
    { LOADP(); phase_peer3<true>(P, lds, vb, G); }
}

extern "C" void kernel_launch(void* const* d_in, const int* in_sizes, int n_in, void* d_out, int out_size, void* d_ws, size_t ws_size, hipStream_t stream) {
    static int ready = 0;
    if (ready == 0) {
        if (n_in != 19 || out_size != NT * DM || ws_size < WS_END) { fprintf(stderr, "kernel_launch: unexpected sizes n_in %d out %d ws %zu\n", n_in, out_size, ws_size); ready = -1; return; }
        if (hipFuncSetAttribute((const void*)mega_kernel, hipFuncAttributeMaxDynamicSharedMemorySize, LDS_BYTES) != hipSuccess) { fprintf(stderr, "kernel_launch: hipFuncSetAttribute failed\n"); ready = -1; return; }
        ready = 1;
    }
    if (ready < 0) return;
    Args a{};
    const float** pp = (const float**)&a.p;
    for (int i = 0; i < 19; ++i) pp[i] = (const float*)d_in[i];
    a.p.out = (float*)d_out; a.p.ws = (unsigned char*)d_ws;
    if (hipMemsetAsync((char*)d_ws + WS_CTL, 0, CTL_ZERO_BYTES, stream) != hipSuccess) { fprintf(stderr, "kernel_launch: memset failed\n"); return; }
    hipLaunchKernelGGL(mega_kernel, dim3(256), dim3(NTHREADS), LDS_BYTES, stream, a);
}
```
